# Optimizing an MI355X kernel written in HIP

```python
import jax, jax.numpy as jnp
from jax import lax
import numpy as np

D_MODEL = 1024
BATCH = 8
SEQ = 4096
DEPTH = 1

CHUNK = 64
N_META = 16
Q_BLOCK = 128
N_PAD = Q_BLOCK - N_META
PREFIX = N_PAD + N_META
MIX_WIDTH = D_MODEL
RET_HEADS = 4
RET_DV = (MIX_WIDTH // 2) // RET_HEADS
RET_DK = RET_DV // 2
FOX_HEADS = 8
FOX_DH = (MIX_WIDTH // 2) // FOX_HEADS
D_FF = 2816
CONV_W = 3
ROPE_BASE = 10000.0
EPS = 1e-6
NEG = -1e30

RET_QK = RET_HEADS * RET_DK
RET_V = RET_HEADS * RET_DV
FOX_W = FOX_HEADS * FOX_DH
SPLIT_POINTS = (RET_QK, 2 * RET_QK, 2 * RET_QK + RET_V, 2 * RET_QK + 2 * RET_V,
                2 * RET_QK + 2 * RET_V + FOX_W, 2 * RET_QK + 2 * RET_V + 2 * FOX_W,
                2 * RET_QK + 2 * RET_V + 3 * FOX_W)
IN_WIDTH = 2 * RET_QK + 2 * RET_V + 3 * FOX_W + FOX_HEADS

kernel_name = "hymba_retention_fox_convffn_block"


def rms_norm(x, g):
    xf = x.astype(jnp.float32)
    y = xf * lax.rsqrt(jnp.mean(xf * xf, axis=-1, keepdims=True) + EPS)
    return (y * g.astype(jnp.float32)).astype(x.dtype)


def rotary(x, pos):
    half = x.shape[-1] // 2
    inv = 1.0 / (ROPE_BASE ** (jnp.arange(half, dtype=jnp.float32) / half))
    ang = pos.astype(jnp.float32)[:, None] * inv[None, :]
    cos = jnp.cos(ang)[None, :, None, :]
    sin = jnp.sin(ang)[None, :, None, :]
    x1 = x[..., :half].astype(jnp.float32)
    x2 = x[..., half:].astype(jnp.float32)
    return jnp.concatenate([x1 * cos - x2 * sin, x1 * sin + x2 * cos], axis=-1)


def retention(q, k, v, valid):
    B, L, H, dk = q.shape
    dv = v.shape[-1]
    nc = L // CHUNK
    f32 = jnp.float32
    log_g = jnp.log1p(-jnp.exp2(-5.0 - jnp.arange(H, dtype=f32)))
    pos = jnp.arange(L)
    qr = rotary(q, pos)
    kr = rotary(k, pos) * (dk ** -0.5) * valid.astype(f32)[None, :, None, None]
    qc = qr.reshape(B, nc, CHUNK, H, dk)
    kc = kr.reshape(B, nc, CHUNK, H, dk)
    vc = v.astype(f32).reshape(B, nc, CHUNK, H, dv)
    n = jnp.arange(CHUNK, dtype=f32)
    d_intra = jnp.exp(jnp.abs(n[:, None] - n[None, :])[None] * log_g[:, None, None])
    s = jnp.einsum('bcnhd,bcmhd->bchnm', qc, kc) * d_intra[None, None]
    intra = jnp.einsum('bchnm,bcmhe->bcnhe', s, vc)
    w_k = jnp.exp((CHUNK - 1.0 - n)[:, None] * log_g[None, :])
    u = jnp.einsum('bcmhd,bcmhe->bchde', kc * w_k[None, None, :, :, None], vc)
    g_chunk = jnp.exp(CHUNK * log_g)[None, :, None, None]

    def step(r, u_i):
        return g_chunk * r + u_i, r

    _, r_prev = lax.scan(step, jnp.zeros((B, H, dk, dv), f32), jnp.moveaxis(u, 1, 0))
    r_prev = jnp.moveaxis(r_prev, 0, 1)
    w_q = jnp.exp((n + 1.0)[:, None] * log_g[None, :])
    inter = jnp.einsum('bcnhd,bchde->bcnhe', qc * w_q[None, None, :, :, None], r_prev)
    return (intra + inter).reshape(B, L, H, dv)


def forgetting_attention(q, k, v, log_f, valid):
    B, L, H, dh = q.shape
    f32 = jnp.float32
    scale = dh ** -0.5
    c = jnp.cumsum(log_f.astype(f32), axis=1).transpose(0, 2, 1)
    qf, kf, vf = q.astype(f32), k.astype(f32), v.astype(f32)
    pos = jnp.arange(L)
    outs = []
    for blk in range(L // Q_BLOCK):
        q0, q1 = blk * Q_BLOCK, (blk + 1) * Q_BLOCK
        logits = jnp.einsum('bqhd,bkhd->bhqk', qf[:, q0:q1], kf[:, :q1]) * scale
        bias = c[:, :, q0:q1, None] - c[:, :, None, :q1]
        mask = (pos[None, :q1] <= pos[q0:q1, None]) & valid[None, :q1]
        logits = jnp.where(mask[None, None], logits + bias, NEG)
        p = jax.nn.softmax(logits, axis=-1)
        outs.append(jnp.einsum('bhqk,bkhd->bqhd', p, vf[:, :q1]))
    return jnp.concatenate(outs, axis=1)


def hybrid_mixer(h, w_in, forget_b, ret_norm_g, w_out, valid):
    B, L, _ = h.shape
    proj = jnp.einsum('bld,de->ble', h, w_in)
    rq, rk, rv, rg, fq, fk, fv, ff = jnp.split(proj, SPLIT_POINTS, axis=-1)
    o_r = retention(rq.reshape(B, L, RET_HEADS, RET_DK), rk.reshape(B, L, RET_HEADS, RET_DK),
                    rv.reshape(B, L, RET_HEADS, RET_DV), valid)
    o_r = o_r * lax.rsqrt(jnp.mean(o_r * o_r, axis=-1, keepdims=True) + EPS)
    o_r = o_r.reshape(B, L, RET_V) * ret_norm_g.astype(jnp.float32) * jax.nn.silu(rg.astype(jnp.float32))
    log_f = jax.nn.log_sigmoid(ff.astype(jnp.float32) + forget_b.astype(jnp.float32))
    o_f = forgetting_attention(fq.reshape(B, L, FOX_HEADS, FOX_DH), fk.reshape(B, L, FOX_HEADS, FOX_DH),
                               fv.reshape(B, L, FOX_HEADS, FOX_DH), log_f, valid).reshape(B, L, FOX_W)
    mixed = jnp.concatenate([o_r, o_f], axis=-1).astype(h.dtype)
    return jnp.einsum('ble,ed->bld', mixed, w_out)


def conv_ffn(h, w_up, conv_w, conv_b, w_down, valid):
    L = h.shape[1]
    up = jnp.einsum('bld,df->blf', h, w_up)
    a, b = jnp.split(up, 2, axis=-1)
    a = a * valid.astype(a.dtype)[None, :, None]
    a_pad = jnp.pad(a, ((0, 0), (CONV_W - 1, 0), (0, 0)))
    acc = conv_b
    for j in range(CONV_W):
        acc = acc + a_pad[:, j:j + L] * conv_w[j]
    return jnp.einsum('blf,fd->bld', jax.nn.silu(acc) * b, w_down)


def setup_inputs(seed: int = 0) -> dict:
    key = jax.random.key(seed)
    ks = jax.random.split(key, 13)
    f32 = jnp.float32
    return {
        "x": jax.random.normal(ks[0], (BATCH, SEQ, D_MODEL), f32),
        "meta_tokens": jax.random.normal(ks[1], (N_META, D_MODEL), f32),
        "attn_norm_g": 1.0 + 0.02 * jax.random.normal(ks[2], (DEPTH, D_MODEL), f32),
        "w_in": jax.random.normal(ks[3], (DEPTH, D_MODEL, IN_WIDTH), f32) * D_MODEL ** -0.5,
        "fox_forget_b": jax.random.uniform(ks[4], (DEPTH, FOX_HEADS), f32, 1.0, 5.0),
        "ret_norm_g": 1.0 + 0.02 * jax.random.normal(ks[5], (DEPTH, RET_V), f32),
        "w_out": jax.random.normal(ks[6], (DEPTH, MIX_WIDTH, D_MODEL), f32) * MIX_WIDTH ** -0.5,
        "ffn_norm_g": 1.0 + 0.02 * jax.random.normal(ks[7], (DEPTH, D_MODEL), f32),
        "w_up": jax.random.normal(ks[8], (DEPTH, D_MODEL, 2 * D_FF), f32) * D_MODEL ** -0.5,
        "conv_w": jax.random.normal(ks[9], (DEPTH, CONV_W, D_FF), f32) * CONV_W ** -0.5,
        "conv_b": 0.02 * jax.random.normal(ks[10], (DEPTH, D_FF), f32),
        "w_down": jax.random.normal(ks[11], (DEPTH, D_FF, D_MODEL), f32) * D_FF ** -0.5,
        "final_norm_g": 1.0 + 0.02 * jax.random.normal(ks[12], (D_MODEL,), f32),
    }


def reference(x, meta_tokens, attn_norm_g, w_in, fox_forget_b, ret_norm_g, w_out,
              ffn_norm_g, w_up, conv_w, conv_b, w_down, final_norm_g):
    B = x.shape[0]
    pad = jnp.zeros((B, N_PAD, D_MODEL), x.dtype)
    meta = jnp.broadcast_to(meta_tokens.astype(x.dtype)[None], (B, N_META, D_MODEL))
    h = jnp.concatenate([pad, meta, x], axis=1)
    valid = jnp.arange(h.shape[1]) >= N_PAD
    for layer in range(DEPTH):
        h = h + hybrid_mixer(rms_norm(h, attn_norm_g[layer]), w_in[layer], fox_forget_b[layer],
                             ret_norm_g[layer], w_out[layer], valid)
        h = h + conv_ffn(rms_norm(h, ffn_norm_g[layer]), w_up[layer], conv_w[layer], conv_b[layer],
                         w_down[layer], valid)
    return rms_norm(h, final_norm_g)[:, PREFIX:]
```

```cpp
#include <hip/hip_runtime.h>
#include <hip/hip_cooperative_groups.h>
#include <cstdio>
#include <cstdint>
namespace cg = cooperative_groups;

namespace pg8 {
#define PG8_LAS __attribute__((address_space(3)))
typedef unsigned short bf16_t;
typedef short bf16x8 __attribute__((ext_vector_type(8)));
typedef float f32x4 __attribute__((ext_vector_type(4)));
typedef unsigned u32x4 __attribute__((ext_vector_type(4)));
constexpr int BM = 256, BK = 64, HALF = 128, HTB = HALF * BK * 2  , STAGE_BYTES = 8 * HTB, NXCD = 8, WGM = 8;

__host__ __device__ __forceinline__ int lds_byte(int r, int c) { const int st = (r >> 4) * 2 + (c >> 5), rr = r & 15, cc = c & 31, ob = rr * 64 + cc * 2; return st * 1024 + (ob ^ (((ob >> 9) & 1) << 5)); }
__host__ __device__ __forceinline__ void stage_rc(int b, int& R, int& C) { const int st = b / 1024, sb = b % 1024, swz = sb ^ (((sb >> 9) & 1) << 5); R = (st >> 1) * 16 + swz / 64; C = (st & 1) * 32 + (swz % 64) / 2; }
__host__ __device__ __forceinline__ int perm32(int rho) { const int n = rho >> 4, i = rho & 15; return 8 * (i >> 2) + 4 * n + (i & 3); }

struct Unit { int pm, pn; };
struct Gemm { const bf16_t* A; const bf16_t* Bt; int M, N, K; };

struct StaticOrder {
    int nM, nN, nwg, G, c;
    __host__ __device__ void init(int M, int N, int G_, int c_) { nM = M / BM; nN = N / BM; nwg = nM * nN; G = G_; c = c_; }
    __host__ __device__ bool next(int i, Unit& u) const {
        const long L = (long)i * G + c; if (L >= nwg) return false;
        int wgid = (int)L; { const int q = nwg / NXCD, r = nwg % NXCD, xcd = wgid % NXCD, off = wgid / NXCD; wgid = (xcd < r ? xcd * (q + 1) : r * (q + 1) + (xcd - r) * q) + off; }
        const int nig = WGM * nN, gid = wgid / nig, fm = gid * WGM, gsz = (nM - fm) < WGM ? (nM - fm) : WGM;
        u.pm = fm + ((wgid % nig) % gsz); u.pn = (wgid % nig) / gsz; return true;
    }
    __device__ __forceinline__ void a_ready(const Unit&) const {}
    __device__ __forceinline__ void done(const Unit&) const {}
};

__device__ __forceinline__ unsigned cvt_pk_bf16(float lo, float hi) { unsigned r; asm volatile("v_cvt_pk_bf16_f32 %0, %1, %2" : "=v"(r) : "v"(lo), "v"(hi)); return r; }
typedef float f32x2 __attribute__((ext_vector_type(2)));
__device__ __forceinline__ f32x2 gelu_pk(f32x2 v) {
    const f32x2 av = __builtin_elementwise_abs(v), d = av * 0.2316418882f + 1.0f;
    f32x2 t; t.x = __builtin_amdgcn_rcpf(d.x); t.y = __builtin_amdgcn_rcpf(d.y);
    f32x2 q = t * 0.5307027145f + (-0.7265760135f); q = q * t + 0.7107068705f; q = q * t + (-0.142248368f); q = q * t + 0.127414796f; q = q * t;
    const f32x2 s = (v * v) * (-0.72134752044f);
    f32x2 e; e.x = __builtin_amdgcn_exp2f(s.x); e.y = __builtin_amdgcn_exp2f(s.y);
    const f32x2 m = v * (q * e), r = v - m;
    f32x2 o; o.x = v.x < 0.f ? m.x : r.x; o.y = v.y < 0.f ? m.y : r.y; return o;
}

template <int ACT  > struct EpiBf16 {
    static constexpr bool PERM = true, AFTER_DRAIN = false; static_assert(ACT == 0 || ACT == 1, "EpiBf16: ACT is 0 (none) or 1 (gelu_pk)");
    bf16_t* O; int ldc; const float* bias; int split_cols; size_t split_stride; float scale0;
    __device__ __forceinline__ void operator()(const f32x4 (&acc)[2][2][4][2], const Unit& u, int wr, int wc, int fr, int fq) const {
        const int row0 = u.pm * BM + wr * 64 + fr; int colt = u.pn * BM; bf16_t* base = O;
        float sc = 1.f; if (split_cols) { const int t = colt / split_cols; base += (size_t)t * split_stride; colt -= t * split_cols; if (t == 0) sc = scale0; }
        const int col0 = colt + wc * 32 + 8 * fq, bcol0 = u.pn * BM + wc * 32 + 8 * fq;
        f32x4 bv[2][2];
#pragma unroll
        for (int bj = 0; bj < 2; ++bj)
#pragma unroll
            for (int n = 0; n < 2; ++n) bv[bj][n] = bias ? *(const f32x4*)(bias + bcol0 + bj * HALF + 4 * n) : (f32x4){0.f, 0.f, 0.f, 0.f};
#pragma unroll
        for (int ai = 0; ai < 2; ++ai)
#pragma unroll
            for (int m = 0; m < 4; ++m) { bf16_t* rowp = base + (size_t)(row0 + ai * HALF + m * 16) * ldc + col0;
#pragma unroll
                for (int bj = 0; bj < 2; ++bj) { f32x4 v0 = acc[ai][bj][m][0] + bv[bj][0], v1 = acc[ai][bj][m][1] + bv[bj][1];
                    if (ACT == 1) { f32x2 a = gelu_pk((f32x2){v0[0], v0[1]}), b = gelu_pk((f32x2){v0[2], v0[3]}), c = gelu_pk((f32x2){v1[0], v1[1]}), d = gelu_pk((f32x2){v1[2], v1[3]});
                        v0 = (f32x4){a.x, a.y, b.x, b.y}; v1 = (f32x4){c.x, c.y, d.x, d.y}; }
                    v0 = v0 * sc; v1 = v1 * sc; u32x4 w; w.x = cvt_pk_bf16(v0[0], v0[1]); w.y = cvt_pk_bf16(v0[2], v0[3]); w.z = cvt_pk_bf16(v1[0], v1[1]); w.w = cvt_pk_bf16(v1[2], v1[3]);
                    *(u32x4*)(rowp + bj * HALF) = w; } }
    }
};

__device__ __forceinline__ void unpack_bf16x8(const u32x4 w, float (&o)[8]) {
#pragma unroll
    for (int i = 0; i < 4; ++i) { o[2 * i] = __uint_as_float(w[i] << 16); o[2 * i + 1] = __uint_as_float(w[i] & 0xffff0000u); }
}
struct EpiProj {
    static constexpr bool PERM = true, AFTER_DRAIN = false;
    bf16_t* O; int ldc; unsigned* norms;
    __device__ __forceinline__ void operator()(const f32x4 (&acc)[2][2][4][2], const Unit& u, int wr, int wc, int fr, int fq) const {
        const int row0 = u.pm * BM + wr * 64 + fr + 128 * (u.pm / 16 + 1);
        const int col0 = u.pn * BM + wc * 32 + 8 * fq;
        if (u.pn >= 6 && u.pn < 10) {
            const int which = (u.pn >= 8) ? 1 : 0, b = u.pm / 16;
#pragma unroll
            for (int bj = 0; bj < 2; ++bj) { float mx = 0.f;
#pragma unroll
                for (int ai = 0; ai < 2; ++ai)
#pragma unroll
                    for (int m = 0; m < 4; ++m) { const f32x4 v0 = acc[ai][bj][m][0], v1 = acc[ai][bj][m][1];
                        float ss = (v0[0] * v0[0] + v0[1] * v0[1]) + (v0[2] * v0[2] + v0[3] * v0[3]) + (v1[0] * v1[0] + v1[1] * v1[1]) + (v1[2] * v1[2] + v1[3] * v1[3]);
                        ss += __shfl_xor(ss, 16); ss += __shfl_xor(ss, 32); mx = fmaxf(mx, ss); }
                mx = fmaxf(mx, __shfl_xor(mx, 1)); mx = fmaxf(mx, __shfl_xor(mx, 2)); mx = fmaxf(mx, __shfl_xor(mx, 4)); mx = fmaxf(mx, __shfl_xor(mx, 8));
                const int head = 4 * (u.pn & 1) + 2 * bj + (wc >> 1);
                if (fr == 0 && fq == 0) atomicMax(norms + ((b * 8 + head) * 3 + which) * 2 + (wc & 1), __float_as_uint(mx)); }
        }
#pragma unroll
        for (int ai = 0; ai < 2; ++ai)
#pragma unroll
            for (int m = 0; m < 4; ++m) { bf16_t* rowp = O + (size_t)(row0 + ai * HALF + m * 16) * ldc + col0;
#pragma unroll
                for (int bj = 0; bj < 2; ++bj) { const f32x4 v0 = acc[ai][bj][m][0], v1 = acc[ai][bj][m][1];
                    u32x4 w; w.x = cvt_pk_bf16(v0[0], v0[1]); w.y = cvt_pk_bf16(v0[2], v0[3]); w.z = cvt_pk_bf16(v1[0], v1[1]); w.w = cvt_pk_bf16(v1[2], v1[3]);
                    *(u32x4*)(rowp + bj * HALF) = w; } }
    }
};
struct EpiRes1 {
    static constexpr bool PERM = true, AFTER_DRAIN = false;
    const float* X; bf16_t* H1; float* rowss; int ldc;
    __device__ __forceinline__ void operator()(const f32x4 (&acc)[2][2][4][2], const Unit& u, int wr, int wc, int fr, int fq) const {
        const int row0 = u.pm * BM + wr * 64 + fr, col0 = u.pn * BM + wc * 32 + 8 * fq;
#pragma unroll
        for (int ai = 0; ai < 2; ++ai)
#pragma unroll
            for (int m = 0; m < 4; ++m) { const int row = row0 + ai * HALF + m * 16; const size_t off = (size_t)row * ldc + col0; float ss = 0.f;
#pragma unroll
                for (int bj = 0; bj < 2; ++bj) { const f32x4 x0 = __builtin_nontemporal_load((const f32x4*)(X + off + bj * HALF)), x1 = __builtin_nontemporal_load((const f32x4*)(X + off + bj * HALF + 4));
                    const f32x4 v0 = acc[ai][bj][m][0] + x0, v1 = acc[ai][bj][m][1] + x1;
                    ss += (v0[0] * v0[0] + v0[1] * v0[1]) + (v0[2] * v0[2] + v0[3] * v0[3]) + (v1[0] * v1[0] + v1[1] * v1[1]) + (v1[2] * v1[2] + v1[3] * v1[3]);
                    u32x4 w; w.x = cvt_pk_bf16(v0[0], v0[1]); w.y = cvt_pk_bf16(v0[2], v0[3]); w.z = cvt_pk_bf16(v1[0], v1[1]); w.w = cvt_pk_bf16(v1[2], v1[3]);
                    *(u32x4*)(H1 + off + bj * HALF) = w; }
                ss += __shfl_xor(ss, 16); ss += __shfl_xor(ss, 32);
                if (fq == 0 && rowss) atomicAdd(rowss + row, ss); }
    }
};
struct EpiRes2 {
    static constexpr bool PERM = true, AFTER_DRAIN = false;
    const bf16_t* H1; float* OUT; float* rowss; int ldc;
    __device__ __forceinline__ void operator()(const f32x4 (&acc)[2][2][4][2], const Unit& u, int wr, int wc, int fr, int fq) const {
        const int row0 = u.pm * BM + wr * 64 + fr, col0 = u.pn * BM + wc * 32 + 8 * fq;
#pragma unroll
        for (int ai = 0; ai < 2; ++ai)
#pragma unroll
            for (int m = 0; m < 4; ++m) { const int row = row0 + ai * HALF + m * 16; const size_t off = (size_t)row * ldc + col0; float ss = 0.f;
#pragma unroll
                for (int bj = 0; bj < 2; ++bj) { float hv[8]; unpack_bf16x8(*(const u32x4*)(H1 + off + bj * HALF), hv);
                    const f32x4 v0 = acc[ai][bj][m][0] + (f32x4){hv[0], hv[1], hv[2], hv[3]}, v1 = acc[ai][bj][m][1] + (f32x4){hv[4], hv[5], hv[6], hv[7]};
                    ss += (v0[0] * v0[0] + v0[1] * v0[1]) + (v0[2] * v0[2] + v0[3] * v0[3]) + (v1[0] * v1[0] + v1[1] * v1[1]) + (v1[2] * v1[2] + v1[3] * v1[3]);
                    *(f32x4*)(OUT + off + bj * HALF) = v0; *(f32x4*)(OUT + off + bj * HALF + 4) = v1; }
                ss += __shfl_xor(ss, 16); ss += __shfl_xor(ss, 32);
                if (fq == 0) atomicAdd(rowss + row, ss); }
    }
};
struct EpiRes2N {
    static constexpr bool PERM = true, AFTER_DRAIN = false;
    const bf16_t* H1; float* OUT; float* rowss; unsigned* cnt; const float* fg; int ldc;
    __device__ __forceinline__ void operator()(f32x4 (&acc)[2][2][4][2], const Unit& u, int wr, int wc, int fr, int fq) const {
        const int row0 = u.pm * BM + wr * 64 + fr, col0 = u.pn * BM + wc * 32 + 8 * fq;
#pragma unroll
        for (int ai = 0; ai < 2; ++ai)
#pragma unroll
            for (int m = 0; m < 4; ++m) { const int row = row0 + ai * HALF + m * 16; const size_t off = (size_t)row * ldc + col0; float ss = 0.f;
#pragma unroll
                for (int bj = 0; bj < 2; ++bj) { float hv[8]; unpack_bf16x8(*(const u32x4*)(H1 + off + bj * HALF), hv);
                    const f32x4 v0 = acc[ai][bj][m][0] + (f32x4){hv[0], hv[1], hv[2], hv[3]}, v1 = acc[ai][bj][m][1] + (f32x4){hv[4], hv[5], hv[6], hv[7]};
                    ss += (v0[0] * v0[0] + v0[1] * v0[1]) + (v0[2] * v0[2] + v0[3] * v0[3]) + (v1[0] * v1[0] + v1[1] * v1[1]) + (v1[2] * v1[2] + v1[3] * v1[3]);
                    acc[ai][bj][m][0] = v0; acc[ai][bj][m][1] = v1; }
                ss += __shfl_xor(ss, 16); ss += __shfl_xor(ss, 32);
                if (fq == 0) atomicAdd(rowss + row, ss); }
        asm volatile("s_waitcnt vmcnt(0)" ::: "memory");
        unsigned* c = cnt + 64 * u.pm;
        if (fr == 0 && fq == 0) __hip_atomic_fetch_add(c, 1u, __ATOMIC_RELAXED, __HIP_MEMORY_SCOPE_AGENT);
        { unsigned spins = 0u;
          while ((unsigned)__builtin_amdgcn_readfirstlane((int)__hip_atomic_load(c, __ATOMIC_RELAXED, __HIP_MEMORY_SCOPE_AGENT)) < 32u && ++spins < (1u << 18)) __builtin_amdgcn_s_sleep(2); }
        __builtin_amdgcn_fence(__ATOMIC_ACQUIRE, "agent");
        f32x4 gv[2][2];
#pragma unroll
        for (int bj = 0; bj < 2; ++bj) { gv[bj][0] = *(const f32x4*)(fg + col0 + bj * HALF); gv[bj][1] = *(const f32x4*)(fg + col0 + bj * HALF + 4); }
#pragma unroll
        for (int ai = 0; ai < 2; ++ai)
#pragma unroll
            for (int m = 0; m < 4; ++m) { const int row = row0 + ai * HALF + m * 16; const size_t off = (size_t)row * ldc + col0;
                const float tot = __hip_atomic_load(rowss + row, __ATOMIC_RELAXED, __HIP_MEMORY_SCOPE_AGENT);
                const float rs = __builtin_amdgcn_rsqf(tot * (1.0f / 1024.0f) + 1e-6f);
#pragma unroll
                for (int bj = 0; bj < 2; ++bj) { *(f32x4*)(OUT + off + bj * HALF) = acc[ai][bj][m][0] * rs * gv[bj][0]; *(f32x4*)(OUT + off + bj * HALF + 4) = acc[ai][bj][m][1] * rs * gv[bj][1]; } }
    }
};
__device__ __forceinline__ float dpp_shr1(float old, float src) { return __int_as_float(__builtin_amdgcn_update_dpp(__float_as_int(old), __float_as_int(src), 0x111, 0xf, 0xf, false)); }
__device__ __forceinline__ float dpp_shr2(float old, float src) { return __int_as_float(__builtin_amdgcn_update_dpp(__float_as_int(old), __float_as_int(src), 0x112, 0xf, 0xf, false)); }
__device__ __forceinline__ float dpp_ror1(float src) { return __int_as_float(__builtin_amdgcn_update_dpp(0, __float_as_int(src), 0x121, 0xf, 0xf, false)); }
__device__ __forceinline__ float dpp_ror2(float src) { return __int_as_float(__builtin_amdgcn_update_dpp(0, __float_as_int(src), 0x122, 0xf, 0xf, false)); }
struct EpiUp {
    static constexpr bool PERM = true, AFTER_DRAIN = false;
    bf16_t* G; const float* rowss; const float* cw; const float* cb; float* atail; float* ahead; float* bhead;
    __device__ __forceinline__ void operator()(const f32x4 (&acc)[2][2][4][2], const Unit& u, int wr, int wc, int fr, int fq) const {
        constexpr int FF = 2816;
        const int f0 = u.pn * 128 + wc * 32 + 8 * fq;
        f32x2 w0[4], w1[4], w2[4], c0[4];
#pragma unroll
        for (int q = 0; q < 2; ++q) { const f32x4 a = *(const f32x4*)(cw + f0 + 4 * q), b = *(const f32x4*)(cw + FF + f0 + 4 * q), c = *(const f32x4*)(cw + 2 * FF + f0 + 4 * q), d = *(const f32x4*)(cb + f0 + 4 * q);
            w0[2 * q] = (f32x2){a[0], a[1]}; w0[2 * q + 1] = (f32x2){a[2], a[3]}; w1[2 * q] = (f32x2){b[0], b[1]}; w1[2 * q + 1] = (f32x2){b[2], b[3]};
            w2[2 * q] = (f32x2){c[0], c[1]}; w2[2 * q + 1] = (f32x2){c[2], c[3]}; c0[2 * q] = (f32x2){d[0], d[1]}; c0[2 * q + 1] = (f32x2){d[2], d[3]}; }
#pragma unroll
        for (int ai = 0; ai < 2; ++ai) {
            const int sidx = 4 * u.pm + 2 * ai + wr;
            f32x2 pa[4];
#pragma unroll
            for (int c = 0; c < 4; ++c) pa[c] = (f32x2){0.f, 0.f};
#pragma unroll
            for (int m = 0; m < 4; ++m) {
                const int row = u.pm * BM + ai * HALF + wr * 64 + m * 16 + fr;
                const float rs = __builtin_amdgcn_rsqf(rowss[row] * (1.0f / 1024.0f) + 1e-6f);
                f32x2 a[4], b[4], g[4];
#pragma unroll
                for (int n = 0; n < 2; ++n) { const f32x4 av = acc[ai][0][m][n], bv = acc[ai][1][m][n];
                    a[2 * n] = (f32x2){av[0], av[1]} * rs; a[2 * n + 1] = (f32x2){av[2], av[3]} * rs; b[2 * n] = (f32x2){bv[0], bv[1]} * rs; b[2 * n + 1] = (f32x2){bv[2], bv[3]} * rs; }
#pragma unroll
                for (int c = 0; c < 4; ++c) {
                    f32x2 p1, p2;
                    { const float o1 = (m > 0) ? dpp_ror1(pa[c].x) : 0.f, o2 = (m > 0) ? dpp_ror2(pa[c].x) : 0.f; p1.x = dpp_shr1(o1, a[c].x); p2.x = dpp_shr2(o2, a[c].x); }
                    { const float o1 = (m > 0) ? dpp_ror1(pa[c].y) : 0.f, o2 = (m > 0) ? dpp_ror2(pa[c].y) : 0.f; p1.y = dpp_shr1(o1, a[c].y); p2.y = dpp_shr2(o2, a[c].y); }
                    const f32x2 z = c0[c] + w0[c] * p2 + w1[c] * p1 + w2[c] * a[c];
                    const f32x2 t = z * (-1.4426950408889634f);
                    f32x2 sg; sg.x = __builtin_amdgcn_rcpf(1.0f + __builtin_amdgcn_exp2f(t.x)); sg.y = __builtin_amdgcn_rcpf(1.0f + __builtin_amdgcn_exp2f(t.y));
                    g[c] = (z * b[c]) * sg;
                }
                u32x4 w; w.x = cvt_pk_bf16(g[0].x, g[0].y); w.y = cvt_pk_bf16(g[1].x, g[1].y); w.z = cvt_pk_bf16(g[2].x, g[2].y); w.w = cvt_pk_bf16(g[3].x, g[3].y);
                *(u32x4*)(G + (size_t)row * FF + f0) = w;
                if (m == 3 && fr >= 14) { float* p = atail + (size_t)(sidx * 2 + (fr - 14)) * FF + f0; *(f32x4*)p = (f32x4){a[0].x, a[0].y, a[1].x, a[1].y}; *(f32x4*)(p + 4) = (f32x4){a[2].x, a[2].y, a[3].x, a[3].y}; }
                if (m == 0 && fr < 2) { float* p = ahead + (size_t)(sidx * 2 + fr) * FF + f0; *(f32x4*)p = (f32x4){a[0].x, a[0].y, a[1].x, a[1].y}; *(f32x4*)(p + 4) = (f32x4){a[2].x, a[2].y, a[3].x, a[3].y};
                    float* q = bhead + (size_t)(sidx * 2 + fr) * FF + f0; *(f32x4*)q = (f32x4){b[0].x, b[0].y, b[1].x, b[1].y}; *(f32x4*)(q + 4) = (f32x4){b[2].x, b[2].y, b[3].x, b[3].y}; }
#pragma unroll
                for (int c = 0; c < 4; ++c) pa[c] = a[c];
            }
        }
    }
};

template <class Epi, class Sched, bool ALIGN_EPI = false, bool SP2 = false>
__device__ __forceinline__ void gemm_phase(PG8_LAS unsigned char* lds, const Gemm g, const Sched& S, const Epi& E) {
    int tid_ = threadIdx.x; asm volatile("" : "+v"(tid_));
    const int tid = tid_, wid = __builtin_amdgcn_readfirstlane(tid >> 6), lane = tid & 63, wr = wid >> 2, wc = wid & 3, fr = lane & 15, fq = lane >> 4;
    const int K = g.K, nt = K / BK;
    unsigned voffA[2], voffB[2];
#pragma unroll
    for (int i = 0; i < 2; ++i) { int R, C; stage_rc(tid * 16 + i * 8192, R, C); const int Rb = Epi::PERM ? ((R & ~31) + perm32(R & 31)) : R;
        voffA[i] = (unsigned)(R * K + C) * 2u; voffB[i] = (unsigned)(Rb * K + C) * 2u; }
    const size_t kstep = (size_t)(BK * 2);
    const size_t hstep = (size_t)HALF * K * 2;
    const size_t tstep = 2 * hstep;
    const unsigned ldsw = (unsigned)wid * 1024u;
    const int aoff = lds_byte(wr * 64 + fr, fq * 8), boff = lds_byte(wc * 32 + fr, fq * 8);
#define PG8_SA(b, h) (((b) * 2 + (h)) * HTB)
#define PG8_SB(b, h) ((4 + (b) * 2 + (h)) * HTB)
#define PG8_STAGE(bufoff, gbase, voff) do { _Pragma("unroll") for (int _i = 0; _i < 2; ++_i) \
        __builtin_amdgcn_global_load_lds((const unsigned*)((const char*)(gbase) + (voff)[_i]), (PG8_LAS unsigned*)(lds + (bufoff) + ldsw + _i * 8192), 16, 0, 0); } while (0)
#define PG8_LDA(dst, b, h) do { _Pragma("unroll") for (int m = 0; m < 4; ++m) _Pragma("unroll") for (int k = 0; k < 2; ++k) dst[m][k] = *(const PG8_LAS bf16x8*)(lds + PG8_SA(b, h) + aoff + m * 2048 + k * 1024); } while (0)
#define PG8_LDB(dst, b, h) do { _Pragma("unroll") for (int n = 0; n < 2; ++n) _Pragma("unroll") for (int k = 0; k < 2; ++k) dst[n][k] = *(const PG8_LAS bf16x8*)(lds + PG8_SB(b, h) + boff + n * 2048 + k * 1024); } while (0)
#define PG8_MMA(ai, bj, At, Bt) do { __builtin_amdgcn_s_setprio(1); _Pragma("unroll") for (int m = 0; m < 4; ++m) _Pragma("unroll") for (int n = 0; n < 2; ++n) _Pragma("unroll") for (int k = 0; k < 2; ++k) \
        acc[ai][bj][m][n] = __builtin_amdgcn_mfma_f32_16x16x32_bf16(Bt[n][k], At[m][k], acc[ai][bj][m][n], 0, 0, 0); __builtin_amdgcn_s_setprio(0); } while (0)
#define PG8_WAIT_V(n) asm volatile("s_waitcnt vmcnt(" #n ")" ::: "memory")
#define PG8_WAIT_L(n) asm volatile("s_waitcnt lgkmcnt(" #n ")" ::: "memory")
#define PG8_BAR __builtin_amdgcn_s_barrier()
#define PG8_SCHED __builtin_amdgcn_sched_barrier(0)
    Unit cur, nxt; int ui = 0;
    if (!S.next(0, cur)) return;
    f32x4 acc[2][2][4][2];
#pragma unroll
    for (int a = 0; a < 2; ++a)
#pragma unroll
        for (int b = 0; b < 2; ++b)
#pragma unroll
            for (int m = 0; m < 4; ++m)
#pragma unroll
                for (int n = 0; n < 2; ++n) acc[a][b][m][n] = (f32x4){0.f, 0.f, 0.f, 0.f};
    bf16x8 At[4][2], B0[2][2], B1[2][2];
    const char* cA = (const char*)g.A + (size_t)cur.pm * tstep; const char* cB = (const char*)g.Bt + (size_t)cur.pn * tstep;
    S.a_ready(cur);
    if constexpr (SP2) {
        PG8_STAGE(PG8_SB(0, 0), cB, voffB); PG8_STAGE(PG8_SB(0, 1), cB + hstep, voffB); PG8_STAGE(PG8_SA(0, 0), cA, voffA); PG8_STAGE(PG8_SA(0, 1), cA + hstep, voffA);
        if (wr == 1) PG8_BAR;
        PG8_WAIT_V(2); PG8_BAR;
        PG8_STAGE(PG8_SB(1, 0), cB + kstep, voffB); PG8_STAGE(PG8_SA(1, 0), cA + kstep, voffA); PG8_STAGE(PG8_SB(1, 1), cB + hstep + kstep, voffB);
        PG8_WAIT_V(6); PG8_BAR;
    } else {
        PG8_STAGE(PG8_SB(0, 0), cB, voffB); PG8_STAGE(PG8_SA(0, 0), cA, voffA); PG8_STAGE(PG8_SB(0, 1), cB + hstep, voffB); PG8_STAGE(PG8_SA(0, 1), cA + hstep, voffA);
        if (wr == 1) PG8_BAR;
        PG8_WAIT_V(4); PG8_BAR;
        PG8_STAGE(PG8_SB(1, 0), cB + kstep, voffB); PG8_STAGE(PG8_SA(1, 0), cA + kstep, voffA); PG8_STAGE(PG8_SB(1, 1), cB + hstep + kstep, voffB);
        PG8_WAIT_V(6); PG8_BAR;
    }
    for (;;) {
        const bool has_next = S.next(ui + 1, nxt);
        const char* nA = has_next ? (const char*)g.A + (size_t)nxt.pm * tstep : cA; const char* nB = has_next ? (const char*)g.Bt + (size_t)nxt.pn * tstep : cB;
        for (int t = 0; t < nt; t += 2) {
            const bool last = (t == nt - 2);
            const char* a1 = cA + (size_t)(t + 1) * kstep;
            const char* a2 = last ? nA : cA + (size_t)(t + 2) * kstep; const char* b2 = last ? nB : cB + (size_t)(t + 2) * kstep;
            const char* a3 = a2 + kstep; const char* b3 = b2 + kstep;
            if (last && has_next) S.a_ready(nxt);
            if constexpr (SP2) {
            PG8_LDB(B0, 0, 0); PG8_LDB(B1, 0, 1); PG8_SCHED; PG8_LDA(At, 0, 0); PG8_STAGE(PG8_SA(1, 1), a1 + hstep, voffA);
            PG8_WAIT_V(8); PG8_WAIT_L(0); PG8_BAR; PG8_MMA(0, 0, At, B0); PG8_MMA(0, 1, At, B1); PG8_BAR; PG8_SCHED;
            PG8_LDA(At, 0, 1); PG8_STAGE(PG8_SB(0, 0), b2, voffB); PG8_STAGE(PG8_SB(0, 1), b2 + hstep, voffB); PG8_STAGE(PG8_SA(0, 0), a2, voffA);
            PG8_WAIT_V(8); PG8_WAIT_L(0); PG8_BAR; PG8_MMA(1, 0, At, B0); PG8_MMA(1, 1, At, B1); PG8_BAR; PG8_SCHED;
            PG8_LDB(B0, 1, 0); PG8_LDB(B1, 1, 1); PG8_SCHED; PG8_LDA(At, 1, 0); PG8_STAGE(PG8_SA(0, 1), a2 + hstep, voffA);
            PG8_WAIT_V(8); PG8_WAIT_L(0); PG8_BAR; PG8_MMA(0, 0, At, B0); PG8_MMA(0, 1, At, B1); PG8_BAR; PG8_SCHED;
            PG8_LDA(At, 1, 1); PG8_STAGE(PG8_SB(1, 0), b3, voffB); PG8_STAGE(PG8_SB(1, 1), b3 + hstep, voffB); PG8_STAGE(PG8_SA(1, 0), a3, voffA);
            PG8_WAIT_V(8); PG8_WAIT_L(0); PG8_BAR; PG8_MMA(1, 0, At, B0); PG8_MMA(1, 1, At, B1); PG8_BAR; PG8_SCHED;
            } else {
            PG8_LDB(B0, 0, 0); PG8_SCHED; PG8_LDA(At, 0, 0); PG8_STAGE(PG8_SA(1, 1), a1 + hstep, voffA);
            PG8_WAIT_L(8); PG8_BAR; PG8_WAIT_L(0); PG8_MMA(0, 0, At, B0); PG8_BAR; PG8_SCHED;
            PG8_LDB(B1, 0, 1); PG8_STAGE(PG8_SB(0, 0), b2, voffB);
            PG8_BAR; PG8_WAIT_L(0); PG8_MMA(0, 1, At, B1); PG8_BAR;
            PG8_LDA(At, 0, 1); PG8_STAGE(PG8_SA(0, 0), a2, voffA);
            PG8_BAR; PG8_WAIT_L(0); PG8_MMA(1, 0, At, B0); PG8_BAR; PG8_SCHED;
            PG8_STAGE(PG8_SB(0, 1), b2 + hstep, voffB);
            PG8_WAIT_V(6); PG8_BAR; PG8_MMA(1, 1, At, B1); PG8_BAR;
            PG8_LDB(B0, 1, 0); PG8_SCHED; PG8_LDA(At, 1, 0); PG8_STAGE(PG8_SA(0, 1), a2 + hstep, voffA);
            PG8_WAIT_L(8); PG8_BAR; PG8_WAIT_L(0); PG8_MMA(0, 0, At, B0); PG8_BAR; PG8_SCHED;
            PG8_LDB(B1, 1, 1); PG8_STAGE(PG8_SB(1, 0), b3, voffB);
            PG8_BAR; PG8_WAIT_L(0); PG8_MMA(0, 1, At, B1); PG8_BAR;
            PG8_LDA(At, 1, 1); PG8_STAGE(PG8_SA(1, 0), a3, voffA);
            PG8_BAR; PG8_WAIT_L(0); PG8_MMA(1, 0, At, B0); PG8_BAR; PG8_SCHED;
            PG8_STAGE(PG8_SB(1, 1), b3 + hstep, voffB);
            PG8_WAIT_V(6); PG8_BAR; PG8_MMA(1, 1, At, B1); PG8_BAR;
            }
        }
        if constexpr (ALIGN_EPI) { if (wr == 0) PG8_BAR; }
        if constexpr (!Epi::AFTER_DRAIN) { E(acc, cur, wr, wc, fr, fq); S.done(cur); }
        if (!has_next) break;
#pragma unroll
        for (int a = 0; a < 2; ++a)
#pragma unroll
            for (int b = 0; b < 2; ++b)
#pragma unroll
                for (int m = 0; m < 4; ++m)
#pragma unroll
                    for (int n = 0; n < 2; ++n) acc[a][b][m][n] = (f32x4){0.f, 0.f, 0.f, 0.f};
        cur = nxt; cA = nA; cB = nB; ++ui;
        if constexpr (ALIGN_EPI) { if (wr == 1) PG8_BAR; }
    }
    PG8_WAIT_V(0);
    if constexpr (!ALIGN_EPI) { if (wr == 0) PG8_BAR; }
    PG8_BAR;
    if constexpr (Epi::AFTER_DRAIN) { E.fused(acc, cur, wr, wc, fr, fq, lds, wid, lane); S.done(cur); }
#undef PG8_SA
#undef PG8_SB
#undef PG8_STAGE
#undef PG8_LDA
#undef PG8_LDB
#undef PG8_MMA
#undef PG8_WAIT_V
#undef PG8_WAIT_L
#undef PG8_BAR
#undef PG8_SCHED
}
}

#include <hip/hip_bf16.h>
#include <cmath>
namespace attn_body {
using bf16=__hip_bfloat16;
using bf16x8=__attribute__((ext_vector_type(8)))short;
using s16x4=__attribute__((ext_vector_type(4)))short;
using f32x16=__attribute__((ext_vector_type(16)))float;
using u32x4=__attribute__((ext_vector_type(4)))unsigned;
typedef float f32x4_t __attribute__((ext_vector_type(4)));
constexpr int BATCH=8,NHEAD=8,SEQ=4224,D=64,DM=3072,OPITCH=1024,OCOL0=512,FRAMES=4096,QOFF=128;
constexpr int NW=8,QBLK=32,QB=QBLK*NW,KVBLK=64,NQB=FRAMES/QB;
constexpr int ATTN_PITCH=DM, ATTN_UNIT_ROWS=QB;
__device__ __forceinline__ int crow(int r,int hi){return (r&3)+8*(r>>2)+4*hi;}
#define SBAR() __builtin_amdgcn_sched_barrier(0)
__device__ __forceinline__ void cmask(f32x16&p0,f32x16&p1,int jb,int qrel,int hi){
  const float NEG=-INFINITY; int kb=64*jb+4*hi;
  #pragma unroll
  for(int r=0;r<16;++r){int kv=kb+(r&3)+8*(r>>2); if(kv>qrel)p0[r]=NEG; if(kv+32>qrel)p1[r]=NEG;}
}

constexpr int NSLOT=3, SLOTB=8192;
constexpr int LDS_K=0, LDS_V=NSLOT*SLOTB, LDS_WS=2*NSLOT*SLOTB, LDS_OST=LDS_WS+NW*64*4, LDS_BIAS=LDS_OST+NW*4096, LDS_BYTES=LDS_BIAS+SEQ*4;
constexpr float C2=0.125f*1.4426950408889634f;
__device__ __forceinline__ void glds16(const void*gsrc,unsigned lds_dst){unsigned keep;
  asm volatile("s_mov_b32 %0, m0\n\ts_mov_b32 m0, %2\n\ts_nop 0\n\tglobal_load_lds_dwordx4 %1, off\n\ts_mov_b32 m0, %0":"=&s"(keep):"v"(gsrc),"s"(lds_dst):"memory");}
__device__ __forceinline__ float max3f(float a,float b,float c){float r;asm("v_max3_f32 %0, %1, %2, %3":"=v"(r):"v"(a),"v"(b),"v"(c));return r;}
__device__ __forceinline__ float max2f(float a,float b){float r;asm("v_max_f32_e32 %0, %1, %2":"=v"(r):"v"(a),"v"(b));return r;}
__device__ __forceinline__ float fadd_s(float a,float b){float r;asm("v_add_f32_e32 %0, %1, %2":"=v"(r):"v"(a),"v"(b));return r;}
__device__ __forceinline__ float fsub_s(float a,float b){float r;asm("v_sub_f32_e32 %0, %1, %2":"=v"(r):"v"(a),"v"(b));return r;}
typedef float f32x2_t __attribute__((ext_vector_type(2))); typedef __bf16 bf16x2_t __attribute__((ext_vector_type(2)));
__device__ __forceinline__ unsigned cvtpk_s(float lo,float hi){f32x2_t v={lo,hi};bf16x2_t b=__builtin_convertvector(v,bf16x2_t);return __builtin_bit_cast(unsigned,b);}
#define WAIT_BAR(N) asm volatile("s_waitcnt vmcnt(" #N ") lgkmcnt(0)\n\ts_barrier":::"memory")

__device__ __forceinline__ void qkt(f32x16&p0,f32x16&p1,const char*Kslot,const bf16x8*qr,int r32,int hi){
  const char*kb=Kslot+hi*1024+r32*16;
  #pragma unroll
  for(int d0=0;d0<4;++d0){
    const bf16x8 b0=*reinterpret_cast<const bf16x8*>(kb+d0*2048);
    const bf16x8 b1=*reinterpret_cast<const bf16x8*>(kb+d0*2048+512);
    {p0=__builtin_amdgcn_mfma_f32_32x32x16_bf16(b0,qr[d0],p0,0,0,0);p1=__builtin_amdgcn_mfma_f32_32x32x16_bf16(b1,qr[d0],p1,0,0,0);}}
}
typedef __attribute__((address_space(3))) const char* lds_cptr;
typedef short v4i16_t __attribute__((ext_vector_type(4)));
__device__ __forceinline__ void kload8(bf16x8*kf,lds_cptr kp){
  kf[0]=*(const __attribute__((address_space(3))) bf16x8*)(kp);      kf[1]=*(const __attribute__((address_space(3))) bf16x8*)(kp+512);
  kf[2]=*(const __attribute__((address_space(3))) bf16x8*)(kp+2048); kf[3]=*(const __attribute__((address_space(3))) bf16x8*)(kp+2560);
  kf[4]=*(const __attribute__((address_space(3))) bf16x8*)(kp+4096); kf[5]=*(const __attribute__((address_space(3))) bf16x8*)(kp+4608);
  kf[6]=*(const __attribute__((address_space(3))) bf16x8*)(kp+6144); kf[7]=*(const __attribute__((address_space(3))) bf16x8*)(kp+6656);
}
__device__ __forceinline__ void kload2(bf16x8*kf,lds_cptr kp,int j){ kf[2*j]=*(const __attribute__((address_space(3))) bf16x8*)(kp+j*2048); kf[2*j+1]=*(const __attribute__((address_space(3))) bf16x8*)(kp+j*2048+512); }
__device__ __forceinline__ s16x4 vtr(lds_cptr p){ return __builtin_bit_cast(s16x4,__builtin_amdgcn_ds_read_tr16_b64_v4i16((__attribute__((address_space(3))) v4i16_t*)p)); }
__device__ __forceinline__ float rowmax(const f32x16&p0,const f32x16&p1){
  float a=max3f(p0[0],p0[1],p1[0]),b=max3f(p0[2],p0[3],p1[1]);a=max3f(a,p1[2],p1[3]);
  #pragma unroll
  for(int r=4;r<16;r+=4){a=max3f(a,p0[r],p0[r+1]);b=max3f(b,p0[r+2],p0[r+3]);a=max3f(a,p1[r],p1[r+1]);b=max3f(b,p1[r+2],p1[r+3]);}
  const float m=max2f(a,b);
  auto rr=__builtin_amdgcn_permlane32_swap(__float_as_uint(m),__float_as_uint(m),false,false);
  return max2f(__uint_as_float(rr[0]),__uint_as_float(rr[1]));
}
__device__ __forceinline__ void pv(f32x16*o,int vb,bf16x8 pa0,bf16x8 pa1,bf16x8 pa2,bf16x8 pa3){
  #pragma unroll
  for(int d0=0;d0<2;++d0){s16x4 lo[4],hi[4];
    #pragma unroll
    for(int ks=0;ks<4;++ks){
      asm volatile("ds_read_b64_tr_b16 %0,%1 offset:%c2":"=&v"(lo[ks]):"v"(vb),"i"(d0*4096+ks*1024):"memory");
      asm volatile("ds_read_b64_tr_b16 %0,%1 offset:%c2":"=&v"(hi[ks]):"v"(vb),"i"(d0*4096+ks*1024+512):"memory");}
    asm volatile("s_waitcnt lgkmcnt(0)":::"memory");SBAR();
    #define PK(k) (bf16x8){lo[k][0],lo[k][1],lo[k][2],lo[k][3],hi[k][0],hi[k][1],hi[k][2],hi[k][3]}
    o[d0]=__builtin_amdgcn_mfma_f32_32x32x16_bf16(pa0,PK(0),o[d0],0,0,0);
    o[d0]=__builtin_amdgcn_mfma_f32_32x32x16_bf16(pa1,PK(1),o[d0],0,0,0);
    o[d0]=__builtin_amdgcn_mfma_f32_32x32x16_bf16(pa2,PK(2),o[d0],0,0,0);
    o[d0]=__builtin_amdgcn_mfma_f32_32x32x16_bf16(pa3,PK(3),o[d0],0,0,0);
    #undef PK
  }
}

#ifndef ATTN_STORE16
#define ATTN_STORE16(p,v) (*(u32x4*)(p)=(v))
#endif
template<int THRL> __device__ __forceinline__ void attn_unit(int b,int h,int qb,const bf16*Q,const bf16*__restrict__ K,const bf16*__restrict__ V,bf16*O,const float*__restrict__ BIAS,int t0,unsigned*qctr,unsigned&qnext,char*shm){
  int tid_=threadIdx.x; asm volatile("":"+v"(tid_)); const int tid=tid_,lane=tid&63,r32=lane&31,hi=lane>>5; const int wid=__builtin_amdgcn_readfirstlane(tid>>6);
  const long rowbase=(long)b*SEQ; const int q0=QOFF+qb*QB;
  const bf16*Qw=Q+(rowbase+q0+wid*QBLK)*DM+h*D;
  const bf16*Kh=K+(rowbase+(long)t0*KVBLK)*DM+h*D,*Vh=V+(rowbase+(long)t0*KVBLK)*DM+h*D;
  const unsigned lds0=(unsigned)(uintptr_t)shm;
  float*wsf=(float*)(shm+LDS_WS)+wid*64;
  const bf16*ksrc=Kh+(long)lane*DM+wid*8;
  const bf16*vsrc=Vh+(long)(16*(wid&3)+(lane>>2))*DM+(wid>>2)*32+(lane&3)*8;
  const unsigned kdst=lds0+LDS_K+wid*1024, vdst=lds0+LDS_V+wid*1024;
  #define DMA_K(t,slot) glds16(ksrc+(long)(t)*KVBLK*DM,(unsigned)__builtin_amdgcn_readfirstlane(kdst+(slot)))
  #define DMA_V(t,slot) glds16(vsrc+(long)(t)*KVBLK*DM,(unsigned)__builtin_amdgcn_readfirstlane(vdst+(slot)))
  const int vb0=(int)(lds0+LDS_V)+((lane>>4)&1)*32+(lane&3)*8+(4*hi+((lane&15)>>2))*64;
  const char*Kbase=shm+LDS_K; bf16x8 kf[8];
  const lds_cptr shm3=(lds_cptr)shm; const lds_cptr kp0=shm3+LDS_K+hi*1024+r32*16; const lds_cptr vp0=shm3+LDS_V+((lane>>4)&1)*32+(lane&3)*8+(4*hi+((lane&15)>>2))*64;
  const int NT=(q0+QB)/KVBLK-t0;
  DMA_K(0,0);DMA_V(0,0);DMA_K(1,SLOTB);
  bf16x8 qr[4];
  #pragma unroll
  for(int d0=0;d0<4;++d0)qr[d0]=*reinterpret_cast<const bf16x8*>(&Qw[(long)r32*DM+d0*16+hi*8]);
  float mhat=0.f,l_reg=0.f;f32x16 o[2];o[0]=f32x16{};o[1]=f32x16{};
  typedef __attribute__((address_space(3))) const f32x4_t* lds_f4p; const lds_f4p biasp=(lds_f4p)(shm3+LDS_BIAS)+hi;
  #define BINIT(C0_,C1_,t_) do{ const lds_f4p bp_=biasp+(t_)*16; _Pragma("unroll") for(int g_=0;g_<4;++g_){ const f32x4_t v0_=bp_[2*g_],v1_=bp_[2*g_+8]; \
      _Pragma("unroll") for(int i_=0;i_<4;++i_){ C0_[4*g_+i_]=v0_[i_]; C1_[4*g_+i_]=v1_[i_]; } } }while(0)
  const int qrel=wid*QBLK+r32;
  #define CMASK(P0,P1,t) do{int jb_=(t)-(NT-4); if(jb_>=0)cmask(P0,P1,jb_,qrel,hi);}while(0)
  bool resc=false;
  #define START(P0,P1) do{ const float rm=rowmax(P0,P1); resc=false; mhat=rm; \
    _Pragma("unroll") for(int r=0;r<16;++r)P0[r]=__builtin_amdgcn_exp2f(P0[r]-mhat); }while(0)
  #define RESC() do{ if(resc){ asm volatile("s_waitcnt lgkmcnt(0)":::"memory"); \
      _Pragma("unroll") for(int d_=0;d_<2;++d_) _Pragma("unroll") for(int r=0;r<16;++r)o[d_][r]*=wsf[crow(r,hi)]; } }while(0)
  f32x16 pA0,pA1,pB0,pB1;
  int sl_prev=0,sl_cur=0,sl_next=SLOTB;
  #define ROT() do{sl_prev=sl_cur;sl_cur=sl_next;sl_next=(sl_next==(NSLOT-1)*SLOTB)?0:sl_next+SLOTB;}while(0)
  DMA_K(2,2*SLOTB);
  { const float* bsrc=BIAS+(long)(b*NHEAD+h)*SEQ+t0*KVBLK; __attribute__((address_space(3))) float* bdst=(__attribute__((address_space(3))) float*)(shm3+LDS_BIAS); for(int i_=tid;i_<q0+QB-t0*KVBLK;i_+=NW*64) bdst[i_]=bsrc[i_]; }
  WAIT_BAR(3);
  BINIT(pA0,pA1,0); qkt(pA0,pA1,Kbase,qr,r32,hi);asm volatile("s_nop 15\n\ts_nop 7":"+v"(pA0),"+v"(pA1));CMASK(pA0,pA1,0);
  START(pA0,pA1);
  _Pragma("unroll") for(int r=0;r<16;++r)pA1[r]=__builtin_amdgcn_exp2f(pA1[r]-mhat);
  WAIT_BAR(0);
  DMA_K(3,0);DMA_V(1,SLOTB);
  ROT();
  kload8(kf,kp0+sl_cur);
  WAIT_BAR(2);
  s16x4 vlo[8],vhi[8]; u32x4 pw0,pw1,pw2,pw3;
  #define PKW(P,B) cvtpk_s(P[B],P[B+1])
  #define PAF(k) __builtin_bit_cast(bf16x8,pw##k)
  #define VFR(i) (bf16x8){vlo[i][0],vlo[i][1],vlo[i][2],vlo[i][3],vhi[i][0],vhi[i][1],vhi[i][2],vhi[i][3]}
  #define PIN(x) asm volatile("":"+v"(x))
  #define MX3(a,b,c) __builtin_fmaxf(__builtin_fmaxf((a),(b)),(c))
  #define GAPA(MF,A0,A1,A2,A3,W0,W1,PW) do{ MF; sacc+=A0; sacc+=A1; sacc+=A2; sacc+=A3; PIN(sacc); W0; W1; PIN(PW); SBAR(); }while(0)
  #define EX(v) __builtin_amdgcn_exp2f(v)
  #define GAPB(MF,X,B) do{ MF; X[B]=EX(X[B]-mhat); X[B+1]=EX(X[B+1]-mhat); X[B+2]=EX(X[B+2]-mhat); X[B+3]=EX(X[B+3]-mhat); PIN(X); SBAR(); }while(0)
  #define VRD(i) do{ vlo[i]=vtr(vp_+(((i)>>2)*4096+((i)&3)*1024)); vhi[i]=vtr(vp_+(((i)>>2)*4096+((i)&3)*1024+512)); }while(0)
  #define KRD(G,j) do{ if(G){ kload2(kf,kp0+sl_next,j); SBAR(); } }while(0)
  #define STEP(C0,C1,P0,P1,t,GK,GV,GL) do{ SBAR(); \
    const lds_cptr vp_=vp0+sl_prev; \
    VRD(0); SBAR(); float sacc=(P0[0]+P0[1]); \
    GAPA(C0=__builtin_amdgcn_mfma_f32_32x32x16_bf16(kf[0],qr[0],C0,0,0,0), P0[2],P0[3],P0[4],P0[5],     pw0[0]=PKW(P0,0), pw0[1]=PKW(P0,2), pw0); \
    VRD(4); SBAR(); GAPA(C1=__builtin_amdgcn_mfma_f32_32x32x16_bf16(kf[1],qr[0],C1,0,0,0), P0[6],P0[7],P0[8],P0[9],     pw0[2]=PKW(P0,4), pw0[3]=PKW(P0,6), pw0); \
    VRD(1); SBAR(); GAPA(C0=__builtin_amdgcn_mfma_f32_32x32x16_bf16(kf[2],qr[1],C0,0,0,0),   P0[10],P0[11],P0[12],P0[13], pw1[0]=PKW(P0,8), pw1[1]=PKW(P0,10), pw1); \
    VRD(5); SBAR(); GAPA(C1=__builtin_amdgcn_mfma_f32_32x32x16_bf16(kf[3],qr[1],C1,0,0,0),   P0[14],P0[15],P1[0],P1[1],   pw1[2]=PKW(P0,12),pw1[3]=PKW(P0,14), pw1); \
    VRD(2); SBAR(); GAPA(C0=__builtin_amdgcn_mfma_f32_32x32x16_bf16(kf[4],qr[2],C0,0,0,0),   P1[2],P1[3],P1[4],P1[5],     pw2[0]=PKW(P1,0), pw2[1]=PKW(P1,2), pw2); \
    VRD(6); SBAR(); GAPA(C1=__builtin_amdgcn_mfma_f32_32x32x16_bf16(kf[5],qr[2],C1,0,0,0),   P1[6],P1[7],P1[8],P1[9],     pw2[2]=PKW(P1,4), pw2[3]=PKW(P1,6), pw2); \
    VRD(3); SBAR(); GAPA(C0=__builtin_amdgcn_mfma_f32_32x32x16_bf16(kf[6],qr[3],C0,0,0,0),   P1[10],P1[11],P1[12],P1[13], pw3[0]=PKW(P1,8), pw3[1]=PKW(P1,10), pw3); \
    VRD(7); SBAR(); GAPA(C1=__builtin_amdgcn_mfma_f32_32x32x16_bf16(kf[7],qr[3],C1,0,0,0),   P1[14],P1[15],0.f,0.f,       pw3[2]=PKW(P1,12),pw3[3]=PKW(P1,14), pw3); \
    l_reg+=sacc; \
    if(GK){DMA_K((t)+3,sl_cur);} if(GV){DMA_V((t)+1,sl_next);} \
    BINIT(P0,P1,(t)+1); \
    CMASK(C0,C1,t); \
    { float a=MX3(C0[0],C0[1],C1[0]),b=MX3(C0[2],C0[3],C1[1]); a=MX3(a,C1[2],C1[3]); \
      _Pragma("unroll") for(int r=4;r<16;r+=4){a=MX3(a,C0[r],C0[r+1]);b=MX3(b,C0[r+2],C0[r+3]);a=MX3(a,C1[r],C1[r+1]);b=MX3(b,C1[r+2],C1[r+3]);} \
      float rm=__builtin_fmaxf(a,b); { auto rr=__builtin_amdgcn_permlane32_swap(__float_as_uint(rm),__float_as_uint(rm),false,false); rm=__builtin_fmaxf(__uint_as_float(rr[0]),__uint_as_float(rr[1])); } \
      resc=false; \
      const float rmr=rm-mhat; \
      if(__any(rmr>(float)THRL)){ const float dl=__builtin_fmaxf(rmr,0.f); mhat+=dl; \
        const float f=__builtin_amdgcn_exp2f(-dl); l_reg*=f; if(hi==0)wsf[r32]=f; resc=true; } } \
    SBAR(); \
    GAPB(o[0]=__builtin_amdgcn_mfma_f32_32x32x16_bf16(PAF(0),VFR(0),o[0],0,0,0), C0,0); \
    GAPB(o[1]=__builtin_amdgcn_mfma_f32_32x32x16_bf16(PAF(0),VFR(4),o[1],0,0,0), C0,4); \
    KRD(GL,0); GAPB(o[0]=__builtin_amdgcn_mfma_f32_32x32x16_bf16(PAF(1),VFR(1),o[0],0,0,0), C0,8); \
    KRD(GL,1); GAPB(o[1]=__builtin_amdgcn_mfma_f32_32x32x16_bf16(PAF(1),VFR(5),o[1],0,0,0), C0,12); \
    KRD(GL,2); GAPB(o[0]=__builtin_amdgcn_mfma_f32_32x32x16_bf16(PAF(2),VFR(2),o[0],0,0,0), C1,0); \
    KRD(GL,3); GAPB(o[1]=__builtin_amdgcn_mfma_f32_32x32x16_bf16(PAF(2),VFR(6),o[1],0,0,0), C1,4); \
    GAPB(o[0]=__builtin_amdgcn_mfma_f32_32x32x16_bf16(PAF(3),VFR(3),o[0],0,0,0), C1,8); \
    GAPB(o[1]=__builtin_amdgcn_mfma_f32_32x32x16_bf16(PAF(3),VFR(7),o[1],0,0,0), C1,12); \
    }while(0)
  int t=1; BINIT(pB0,pB1,1);
  #undef CMASK
  #define CMASK(P0,P1,t) do{}while(0)
  for(;t+5<NT;t+=2){
    STEP(pB0,pB1,pA0,pA1,t,true,true,true);     WAIT_BAR(2); RESC(); ROT();
    STEP(pA0,pA1,pB0,pB1,t+1,true,true,true);   WAIT_BAR(2); RESC(); ROT();
  }
  #undef CMASK
  #define CMASK(P0,P1,t) do{int jb_=(t)-(NT-4); if(jb_>=0)cmask(P0,P1,jb_,qrel,hi);}while(0)
  #define ENDW(tt) do{ if((tt)+3<NT){WAIT_BAR(2);} else if((tt)+2<NT){WAIT_BAR(1);} else {WAIT_BAR(0);} }while(0)
  for(;t+1<NT;t+=2){
    STEP(pB0,pB1,pA0,pA1,t,(t+3<NT),(t+1<NT),(t+1<NT));       ENDW(t);   RESC(); ROT();
    STEP(pA0,pA1,pB0,pB1,t+1,(t+4<NT),(t+2<NT),(t+2<NT));     ENDW(t+1); RESC(); ROT();
  }
  STEP(pB0,pB1,pA0,pA1,NT-1,false,false,false); RESC();
  { float sacc=pB0[0]+pB0[1]; _Pragma("unroll") for(int r=2;r<16;++r)sacc+=pB0[r]; _Pragma("unroll") for(int r=0;r<16;++r)sacc+=pB1[r]; l_reg+=sacc;
    pw0=(u32x4){PKW(pB0,0),PKW(pB0,2),PKW(pB0,4),PKW(pB0,6)};pw1=(u32x4){PKW(pB0,8),PKW(pB0,10),PKW(pB0,12),PKW(pB0,14)};pw2=(u32x4){PKW(pB1,0),PKW(pB1,2),PKW(pB1,4),PKW(pB1,6)};pw3=(u32x4){PKW(pB1,8),PKW(pB1,10),PKW(pB1,12),PKW(pB1,14)};
    SBAR(); pv(o,vb0+sl_cur,PAF(0),PAF(1),PAF(2),PAF(3)); }
  #undef PKW
  #undef PAF
  #undef VFR
  #undef PIN
  #undef MX3
  #undef GAPA
  #undef GAPB
  #undef EX
  #undef VRD
  #undef KRD
  #undef STEP
  #undef ENDW
  if(tid==0)qnext=atomicAdd(qctr,1u);
  {auto rr=__builtin_amdgcn_permlane32_swap(__float_as_uint(l_reg),__float_as_uint(l_reg),false,false);l_reg=__uint_as_float(rr[0])+__uint_as_float(rr[1]);}
  if(hi==0)wsf[32+r32]=l_reg;asm volatile("s_waitcnt lgkmcnt(0)":::"memory");
  float rli[16];
  #pragma unroll
  for(int r=0;r<16;++r)rli[r]=__builtin_amdgcn_rcpf(wsf[32+crow(r,hi)]);
  bf16*Ow=O+((long)b*FRAMES+qb*QB+wid*QBLK)*OPITCH+OCOL0+h*D;
  { bf16*stg=(bf16*)(shm+LDS_OST)+wid*2048;
    #pragma unroll
    for(int r=0;r<16;++r){const int orow=crow(r,hi);
      #pragma unroll
      for(int d0=0;d0<2;++d0)stg[orow*64+d0*32+r32]=__float2bfloat16(o[d0][r]*rli[r]);}
    asm volatile("s_waitcnt lgkmcnt(0)":::"memory");
    #pragma unroll
    for(int i=0;i<4;++i){const int row=i*8+(lane>>3),ch=lane&7; const u32x4 v=*(const u32x4*)(stg+row*64+ch*8); ATTN_STORE16(Ow+(long)row*OPITCH+ch*8,v);} }
  asm volatile("s_waitcnt lgkmcnt(0)\n\ts_barrier":::"memory");
  #undef DMA_K
  #undef DMA_V
  #undef CMASK
  #undef START
  #undef RESC
  #undef ROT
}
constexpr int ATTN_LDS_BYTES=LDS_BYTES;
#undef SBAR
#undef WAIT_BAR
}

#define GAS __attribute__((address_space(1)))
#define LAS __attribute__((address_space(3)))
typedef unsigned short bf16;
typedef unsigned v4u __attribute__((ext_vector_type(4)));
typedef unsigned v2u __attribute__((ext_vector_type(2)));
typedef float f32x4 __attribute__((ext_vector_type(4)));
typedef float f32x16v __attribute__((ext_vector_type(16)));
typedef short bf16x8v __attribute__((ext_vector_type(8)));

constexpr int NWAVES = 8, NTHR = 512;
constexpr int NB = 8, FR = 4096, LP = 4224, DM_ = 1024, MROWS = NB * FR, NPROJ = 3072, INW = 3080, DFF = 2816, NUP = 2 * DFF;
constexpr float EPS_ = 1e-6f, LOG2E = 1.4426950408889634f, C2Q = 0.125f * 1.4426950408889634f;
constexpr float BIAS_INVALID = -3000.0f;
constexpr int C_RQ = 0, C_RK = 256, C_RV = 512, C_RG = 1024, C_FQ = 1536, C_FK = 2048, C_FV = 2560;

constexpr size_t MiB = 1u << 20;
constexpr size_t WS_CTL = 0, CTL_ZERO_BYTES = 262144;
constexpr int CW_BAR = 4096, CW_PANEL = 8192;
static_assert((CW_PANEL + 64 * 128) * 4 <= (int)CTL_ZERO_BYTES, "ctl");
constexpr int CW_NORMS = 1024, CW_CENSUS = 2048, CW_FB = 16384, FB_SEAMS = 24;
static_assert((CW_FB + FB_SEAMS * 17 * 64) * 4 <= (int)CTL_ZERO_BYTES, "ctl");
constexpr int CW_BAR_ = 4096;
constexpr size_t WS_WIN = 2 * MiB, WS_WOUT = 8 * MiB, WS_WUP = 10 * MiB, WS_WDN = 21 * MiB;
constexpr size_t WS_ROPEC = 27 * MiB, WS_ROPES = 27 * MiB + 768 * 1024;
constexpr size_t WS_BIAS = 29 * MiB, WS_LOGF = 31 * MiB, WS_ROWSS = 32 * MiB, WS_ROWSS2 = 32 * MiB + 256 * 1024;
constexpr size_t WS_PROJM = 33 * MiB, WS_UMETA = 33 * MiB + 256 * 1024, WS_MIXM = 33 * MiB + 512 * 1024, WS_H1M = WS_MIXM + 16 * 1024, WS_AMETA = WS_MIXM + 32 * 1024, WS_LOGFM = WS_MIXM + 64 * 1024;
constexpr size_t WS_ATAIL = 34 * MiB, WS_AHEAD = 46 * MiB, WS_BHEAD = 58 * MiB;
constexpr size_t WS_XN = 70 * MiB, WS_MIXED = 134 * MiB, WS_H1 = 198 * MiB, WS_PROJ = 262 * MiB, WS_G = WS_PROJ, WS_END = 460 * MiB;
static_assert(WS_PROJ + (size_t)NB * LP * NPROJ * 2 <= WS_END && WS_G + (size_t)MROWS * DFF * 2 <= WS_END, "ws map");

constexpr int RING_BYTES = 131072, LDSCTL_OFF = RING_BYTES, LDS_BYTES = 147456;

struct Args {
    const float *x, *meta, *attn_g, *w_in, *fox_b, *ret_g, *w_out, *ffn_g, *w_up, *conv_w, *conv_b, *w_down, *final_g;
    float* out; unsigned char* ws;
};

__device__ __forceinline__ unsigned f2bf(float f) { unsigned u = __builtin_bit_cast(unsigned, f); return (u + 0x7fffu + ((u >> 16) & 1u)) >> 16; }
__device__ __forceinline__ unsigned pk2(float lo, float hi) { return f2bf(lo) | (f2bf(hi) << 16); }
__device__ __forceinline__ unsigned pk2h(float lo, float hi) { typedef float f2_ __attribute__((ext_vector_type(2))); typedef __bf16 b2_ __attribute__((ext_vector_type(2))); f2_ v = {lo, hi}; b2_ b = __builtin_convertvector(v, b2_); return __builtin_bit_cast(unsigned, b); }
__device__ __forceinline__ float bf2f(unsigned short v) { return __uint_as_float((unsigned)v << 16); }
__device__ __forceinline__ float wave_sum(float v) {
#pragma unroll
    for (int o = 1; o < 64; o <<= 1) v += __shfl_xor(v, o);
    return v;
}
__device__ __forceinline__ float logsigmoidf_(float z) { return fminf(z, 0.f) - log1pf(expf(-fabsf(z))); }
__device__ __forceinline__ float siluf_(float z) { return z / (1.0f + expf(-z)); }
#define LDS_WAIT() asm volatile("s_waitcnt lgkmcnt(0)" ::: "memory")
__device__ __forceinline__ int launder_v(int v) { asm volatile("" : "+v"(v)); return v; }
#define RELANE() do { tid = launder_v(tid); lane = tid & 63; wave = __builtin_amdgcn_readfirstlane(tid >> 6); } while (0)

__device__ __forceinline__ void p0_transpose_item(const float* W, int ldw, int src0, int k0, bf16* WT, int Kd, int drow0, const float* kg, float sc, LAS float* scr, int lane) {
    float wv[32];
#pragma unroll
    for (int i = 0; i < 32; ++i) wv[i] = __builtin_nontemporal_load(W + (size_t)(k0 + 2 * i + (lane >> 5)) * ldw + src0 + (lane & 31));
#pragma unroll
    for (int i = 0; i < 32; ++i) { const int kk = 2 * i + (lane >> 5); const float g = kg ? kg[k0 + kk] * sc : sc; scr[kk * 33 + (lane & 31)] = wv[i] * g; }
    LDS_WAIT(); asm volatile("" ::: "memory");
    const int c = lane & 7;
#pragma unroll
    for (int j = 0; j < 4; ++j) { const int n = (lane >> 3) + 8 * j; const LAS float* s = scr + (8 * c) * 33 + n;
        v4u o; o.x = pk2h(s[0 * 33], s[1 * 33]); o.y = pk2h(s[2 * 33], s[3 * 33]); o.z = pk2h(s[4 * 33], s[5 * 33]); o.w = pk2h(s[6 * 33], s[7 * 33]);
        *(GAS v4u*)(WT + (size_t)(drow0 + n) * Kd + k0 + 8 * c) = o; }
    LDS_WAIT(); asm volatile("" ::: "memory");
}

__device__ __forceinline__ void m0_item(const Args& A, LAS unsigned char* lds, int item, int tid, int lane, int wave) {
    RELANE();
    unsigned char* ws = A.ws;
    LAS float* hn = (LAS float*)lds;
    for (int rr = 0; rr < 2; ++rr) {
        const int r = 2 * wave + rr; float v[16]; float ss = 0.f;
#pragma unroll
        for (int j = 0; j < 4; ++j) { const f32x4 t = *(const f32x4*)(A.meta + (size_t)r * DM_ + 4 * lane + 256 * j); v[4 * j] = t[0]; v[4 * j + 1] = t[1]; v[4 * j + 2] = t[2]; v[4 * j + 3] = t[3]; ss += (t[0] * t[0] + t[1] * t[1]) + (t[2] * t[2] + t[3] * t[3]); }
        const float rs = 1.0f / sqrtf(wave_sum(ss) * (1.0f / DM_) + EPS_);
#pragma unroll
        for (int j = 0; j < 4; ++j)
#pragma unroll
            for (int i = 0; i < 4; ++i) { const int k = 4 * lane + 256 * j + i; hn[r * DM_ + k] = v[4 * j + i] * rs * A.attn_g[k]; }
    }
    __syncthreads();
    {
        const int c = tid & 15, ks = tid >> 4, n = 16 * item + c;
        float acc[16];
#pragma unroll
        for (int r = 0; r < 16; ++r) acc[r] = 0.f;
        if (n < INW) {
            const float* wp = A.w_in + (size_t)(32 * ks) * INW + n;
#pragma unroll 2
            for (int k4 = 0; k4 < 8; ++k4) { const float w0 = wp[(size_t)(4 * k4) * INW], w1 = wp[(size_t)(4 * k4 + 1) * INW], w2 = wp[(size_t)(4 * k4 + 2) * INW], w3 = wp[(size_t)(4 * k4 + 3) * INW];
#pragma unroll
                for (int r = 0; r < 16; ++r) { const f32x4 hv = *(const LAS f32x4*)(hn + r * DM_ + 32 * ks + 4 * k4);
                    acc[r] += (hv[0] * w0 + hv[1] * w1) + (hv[2] * w2 + hv[3] * w3); } }
        }
        LAS float* red = (LAS float*)(lds + 65536);
#pragma unroll
        for (int r = 0; r < 16; ++r) red[(ks * 16 + r) * 16 + c] = acc[r];
    }
    __syncthreads();
    if (tid < 256) {
        const LAS float* red = (const LAS float*)(lds + 65536);
        const int c = tid & 15, r = tid >> 4, n = 16 * item + c; float s = 0.f;
#pragma unroll
        for (int k = 0; k < 32; ++k) s += red[(k * 16 + r) * 16 + c];
        if (n < INW) {
            ((float*)(ws + WS_PROJM))[r * INW + n] = s;
            if (n >= C_FK && n < NPROJ) { const unsigned short bv = (unsigned short)f2bf(s); bf16* P = (bf16*)(ws + WS_PROJ);
#pragma unroll
                for (int b = 0; b < NB; ++b) P[(size_t)(b * LP + 112 + r) * NPROJ + n] = bv; }
            if (n >= NPROJ) ((float*)(ws + WS_LOGFM))[r * 8 + (n - NPROJ)] = logsigmoidf_(s + A.fox_b[n - NPROJ]);
        }
    }
    __syncthreads();
}

__device__ __forceinline__ void p0_prologue(const Args& A, LAS unsigned char* lds, int vcu, int G, int tid, int lane, int wave) {
    RELANE();
    unsigned char* ws = A.ws;
    const int gw = vcu * NWAVES + wave, NGW = G * NWAVES, gt = vcu * NTHR + tid, NGT = G * NTHR;
    for (int i = gt; i < MROWS; i += NGT) { ((float*)(ws + WS_ROWSS))[i] = 0.f; ((float*)(ws + WS_ROWSS2))[i] = 0.f; }
    if (vcu < 193) m0_item(A, lds, vcu, tid, lane, wave);
    RELANE();
    {
        LAS float* scr = (LAS float*)(lds + wave * 16384);
        constexpr int I_IN = 16 * 96, I_OUT = 16 * 32, I_UP = 16 * 176, I_DN = 44 * 32, NITEMS = I_IN + I_OUT + I_UP + I_DN;
        for (int it = gw; it < NITEMS; it += NGW) {
            int r = it;
            if (r < I_IN) { const int kb = r / 96, nb = r % 96; const float sc = (nb >= C_FQ / 32 && nb < C_FK / 32) ? C2Q : 1.0f;
                p0_transpose_item(A.w_in, INW, 32 * nb, 64 * kb, (bf16*)(ws + WS_WIN), DM_, 32 * nb, nullptr, sc, scr, lane); continue; } r -= I_IN;
            if (r < I_OUT) { const int kb = r / 32, nb = r % 32; p0_transpose_item(A.w_out, DM_, 32 * nb, 64 * kb, (bf16*)(ws + WS_WOUT), DM_, 32 * nb, nullptr, 1.0f, scr, lane); continue; } r -= I_OUT;
            if (r < I_UP) { const int kb = r / 176, nb = r % 176; const int n0 = 32 * nb, p = n0 >> 8, j = n0 & 255; const int src = (j < 128) ? (128 * p + j) : (DFF + 128 * p + (j - 128));
                p0_transpose_item(A.w_up, NUP, src, 64 * kb, (bf16*)(ws + WS_WUP), DM_, n0, A.ffn_g, 1.0f, scr, lane); continue; } r -= I_UP;
            { const int kb = r / 32, nb = r % 32; p0_transpose_item(A.w_down, DM_, 32 * nb, 64 * kb, (bf16*)(ws + WS_WDN), DFF, 32 * nb, nullptr, 1.0f, scr, lane); }
        }
    }
    for (int i = gt; i < LP * 32; i += NGT) { const int pos = i >> 5, j = i & 31;
        const double inv = exp(-9.210340371976184 * (double)j / 32.0);
        const double rev = (double)pos * inv * 0.15915494309189535; const float fr = (float)(rev - floor(rev));
        ((float*)(ws + WS_ROPEC))[i] = __builtin_amdgcn_cosf(fr); ((float*)(ws + WS_ROPES))[i] = __builtin_amdgcn_sinf(fr); }
    for (int i = gt; i < NB * 112 * 128; i += NGT) { const int ch = i & 127, rr = i >> 7, b = rr / 112, t = rr % 112;
        *(GAS v4u*)((bf16*)(ws + WS_PROJ) + (size_t)(b * LP + t) * NPROJ + C_FK + 8 * ch) = (v4u){0u, 0u, 0u, 0u}; }
    RELANE();
    {
        float wff[16][8], gk[16];
#pragma unroll
        for (int j = 0; j < 4; ++j)
#pragma unroll
            for (int i = 0; i < 4; ++i) { const int k = 4 * lane + 256 * j + i; gk[4 * j + i] = A.attn_g[k];
                const f32x4 a = *(const f32x4*)(A.w_in + (size_t)k * INW + NPROJ), b = *(const f32x4*)(A.w_in + (size_t)k * INW + NPROJ + 4);
                wff[4 * j + i][0] = a[0]; wff[4 * j + i][1] = a[1]; wff[4 * j + i][2] = a[2]; wff[4 * j + i][3] = a[3]; wff[4 * j + i][4] = b[0]; wff[4 * j + i][5] = b[1]; wff[4 * j + i][6] = b[2]; wff[4 * j + i][7] = b[3]; }
        const float fbc = A.fox_b[lane >> 3];
        f32x4 vn[4], vn2[4];
        if (gw < MROWS) { const GAS f32x4* xr = (const GAS f32x4*)(A.x + (size_t)gw * DM_) + lane;
#pragma unroll
            for (int j = 0; j < 4; ++j) vn[j] = __builtin_nontemporal_load(xr + 64 * j); }
        if (gw + NGW < MROWS) { const GAS f32x4* xr = (const GAS f32x4*)(A.x + (size_t)(gw + NGW) * DM_) + lane;
#pragma unroll
            for (int j = 0; j < 4; ++j) vn2[j] = __builtin_nontemporal_load(xr + 64 * j); }
        for (int m = gw; m < MROWS; m += NGW) {
            f32x4 v[4]; float ss = 0.f;
#pragma unroll
            for (int j = 0; j < 4; ++j) { v[j] = vn[j]; vn[j] = vn2[j]; ss += (v[j][0] * v[j][0] + v[j][1] * v[j][1]) + (v[j][2] * v[j][2] + v[j][3] * v[j][3]); }
            if (m + 2 * NGW < MROWS) { const GAS f32x4* xr = (const GAS f32x4*)(A.x + (size_t)(m + 2 * NGW) * DM_) + lane;
#pragma unroll
                for (int j = 0; j < 4; ++j) vn2[j] = __builtin_nontemporal_load(xr + 64 * j); }
            const float rs = 1.0f / sqrtf(wave_sum(ss) * (1.0f / DM_) + EPS_);
            float ff[8];
#pragma unroll
            for (int c = 0; c < 8; ++c) ff[c] = 0.f;
            GAS unsigned long long* o8 = (GAS unsigned long long*)((bf16*)(ws + WS_XN) + (size_t)m * DM_) + lane;
#pragma unroll
            for (int j = 0; j < 4; ++j) { float h[4];
#pragma unroll
                for (int i = 0; i < 4; ++i) { h[i] = v[j][i] * rs * gk[4 * j + i];
#pragma unroll
                    for (int c = 0; c < 8; ++c) ff[c] += h[i] * wff[4 * j + i][c]; }
                o8[64 * j] = (unsigned long long)pk2h(h[0], h[1]) | ((unsigned long long)pk2h(h[2], h[3]) << 32); }
            float r4[4], r2[2], r1;
            { const bool up = (lane & 32) != 0;
#pragma unroll
              for (int c = 0; c < 4; ++c) { const float keep = up ? ff[c + 4] : ff[c], send = up ? ff[c] : ff[c + 4]; r4[c] = keep + __shfl_xor(send, 32); } }
            { const bool up = (lane & 16) != 0;
#pragma unroll
              for (int c = 0; c < 2; ++c) { const float keep = up ? r4[c + 2] : r4[c], send = up ? r4[c] : r4[c + 2]; r2[c] = keep + __shfl_xor(send, 16); } }
            { const bool up = (lane & 8) != 0; const float keep = up ? r2[1] : r2[0], send = up ? r2[0] : r2[1]; r1 = keep + __shfl_xor(send, 8); }
            r1 += __shfl_xor(r1, 4); r1 += __shfl_xor(r1, 2); r1 += __shfl_xor(r1, 1);
            if ((lane & 7) == 0) { const int c = lane >> 3; ((float*)(ws + WS_LOGF))[(size_t)((m >> 12) * 8 + c) * FR + (m & (FR - 1))] = logsigmoidf_(r1 + fbc); }
        }
    }
}

__device__ __forceinline__ void cumsum_item(const Args& A, int bh, int lane) {
    lane = launder_v(lane);
    unsigned char* ws = A.ws; const int b = bh >> 3, h = bh & 7;
    float* bias = (float*)(ws + WS_BIAS) + (size_t)bh * LP; const float* lfm = (const float*)(ws + WS_LOGFM); const float* lf = (const float*)(ws + WS_LOGF) + (size_t)bh * FR + 64 * lane;
    f32x4 v[16];
#pragma unroll
    for (int i = 0; i < 16; ++i) v[i] = *(const f32x4*)(lf + 4 * i);
    for (int t = lane; t < 112; t += 64) bias[t] = BIAS_INVALID;
    { const float* pm = (const float*)(ws + WS_PROJM) + C_FK + h * 64 + lane; float mx = 0.f;
      float pv[16];
#pragma unroll
      for (int i = 0; i < 16; ++i) pv[i] = pm[i * INW];
#pragma unroll
      for (int i = 0; i < 16; ++i) mx = fmaxf(mx, wave_sum(pv[i] * pv[i]));
      if (lane == 0) ((unsigned*)(ws + WS_CTL))[CW_NORMS + ((b * 8 + h) * 3 + 2) * 2] = __float_as_uint(mx); }
    float c = 0.f;
    { const float my = (lane >= 1 && lane < 16) ? lfm[lane * 8 + h] : 0.f; float inc = my;
#pragma unroll
      for (int o = 1; o < 16; o <<= 1) { const float t = __shfl_up(inc, o); if (lane >= o) inc += t; }
      if (lane < 16) bias[112 + lane] = -inc * LOG2E;
      c = __shfl(inc, 15); }
    float loc = 0.f;
#pragma unroll
    for (int i = 0; i < 16; ++i) loc += (v[i][0] + v[i][1]) + (v[i][2] + v[i][3]);
    float inc = loc;
#pragma unroll
    for (int o = 1; o < 64; o <<= 1) { const float t = __shfl_up(inc, o); if (lane >= o) inc += t; }
    float run = c + (inc - loc);
    float* bo = bias + 128 + 64 * lane;
#pragma unroll
    for (int i = 0; i < 16; ++i) { f32x4 o; run += v[i][0]; o[0] = -run * LOG2E; run += v[i][1]; o[1] = -run * LOG2E; run += v[i][2]; o[2] = -run * LOG2E; run += v[i][3]; o[3] = -run * LOG2E; *(f32x4*)(bo + 4 * i) = o; }
}

__device__ __forceinline__ void m1_item(const Args& A, LAS unsigned char* lds, int item, int tid, int lane, int wave) {
    RELANE();
    unsigned char* ws = A.ws;
    const float* PM = (const float*)(ws + WS_PROJM); const float* LFM = (const float*)(ws + WS_LOGFM);
    const float* RC = (const float*)(ws + WS_ROPEC); const float* RS = (const float*)(ws + WS_ROPES);
    float* MIXM = (float*)(ws + WS_MIXM); float* UM = (float*)(ws + WS_UMETA);
    LAS float* kk = (LAS float*)lds;
    LAS float* qq = kk + 1024;
    LAS float* vv = qq + 128;
    LAS float* sc = vv + 2048;
    LAS float* part = sc + 32;
    if (item < 4) {
        const int h = item;
        const float lg = log2f(1.0f - exp2f(-5.0f - (float)h));
        { const int i = tid >> 5, j = tid & 31, pos = 112 + i; const float c = RC[pos * 32 + j], s = RS[pos * 32 + j];
          const float x1 = PM[i * INW + C_RK + h * 64 + j], x2 = PM[i * INW + C_RK + h * 64 + j + 32];
          kk[i * 64 + j] = (x1 * c - x2 * s) * 0.125f; kk[i * 64 + j + 32] = (x1 * s + x2 * c) * 0.125f; }
        if (tid < 64) { const int n = tid >> 5, j = tid & 31, i = 14 + n, pos = 112 + i; const float c = RC[pos * 32 + j], s = RS[pos * 32 + j];
          const float x1 = PM[i * INW + C_RQ + h * 64 + j], x2 = PM[i * INW + C_RQ + h * 64 + j + 32];
          qq[n * 64 + j] = x1 * c - x2 * s; qq[n * 64 + j + 32] = x1 * s + x2 * c; }
#pragma unroll
        for (int q = 0; q < 4; ++q) { const int idx = tid + 512 * q, i = idx >> 7, e = idx & 127; vv[idx] = PM[i * INW + C_RV + h * 128 + e]; }
        __syncthreads();
        float wgt[16];
#pragma unroll
        for (int i = 0; i < 16; ++i) wgt[i] = exp2f(lg * (float)(15 - i));
#pragma unroll 4
        for (int q = 0; q < 16; ++q) { const int idx = tid + 512 * q, d = idx >> 7, e = idx & 127; float s = 0.f;
#pragma unroll
            for (int i = 0; i < 16; ++i) s += wgt[i] * kk[i * 64 + d] * vv[i * 128 + e];
            UM[(size_t)h * 8192 + idx] = s; }
        if (tid < 32) { const int n = tid >> 4, i = tid & 15; float s = 0.f;
#pragma unroll 16
            for (int d = 0; d < 64; ++d) s += qq[n * 64 + d] * kk[i * 64 + d];
            sc[tid] = s * exp2f(lg * fabsf((float)(14 + n - i))); }
        __syncthreads();
        float o = 0.f;
        if (tid < 256) { const int n = tid >> 7, e = tid & 127;
#pragma unroll
            for (int i = 0; i < 16; ++i) o += sc[n * 16 + i] * vv[i * 128 + e]; }
        { const float p = wave_sum(o * o); if (lane == 0) part[wave] = p; }
        __syncthreads();
        if (tid < 256) { const int n = tid >> 7, e = tid & 127; const float ss = part[2 * n] + part[2 * n + 1];
            const float gate = PM[(14 + n) * INW + C_RG + h * 128 + e];
            MIXM[n * DM_ + h * 128 + e] = o * (1.0f / sqrtf(ss * (1.0f / 128.0f) + EPS_)) * A.ret_g[h * 128 + e] * siluf_(gate); }
    } else {
        const int hh = item - 4;
        for (int idx = tid; idx < 1024; idx += NTHR) { const int i = idx >> 6, d = idx & 63; kk[idx] = PM[i * INW + C_FK + hh * 64 + d]; vv[idx] = PM[i * INW + C_FV + hh * 64 + d]; }
        if (tid < 128) { const int n = tid >> 6, d = tid & 63; qq[tid] = PM[(14 + n) * INW + C_FQ + hh * 64 + d]; }
        __syncthreads();
        if (tid < 32) { const int n = tid >> 4, i = tid & 15, iq = 14 + n; float v = -INFINITY;
            if (i <= iq) { float s = 0.f;
#pragma unroll 16
                for (int d = 0; d < 64; ++d) s += qq[n * 64 + d] * kk[i * 64 + d];
                float cb = 0.f; for (int j = i + 1; j <= iq; ++j) cb += LFM[j * 8 + hh];
                v = s * 0.125f + cb; }
            sc[tid] = v; }
        __syncthreads();
        if (tid < 128) { const int n = tid >> 6, d = tid & 63; float mx = -INFINITY;
#pragma unroll
            for (int i = 0; i < 16; ++i) mx = fmaxf(mx, sc[n * 16 + i]);
            float l = 0.f, o = 0.f;
#pragma unroll
            for (int i = 0; i < 16; ++i) { const float p = expf(sc[n * 16 + i] - mx); l += p; o += p * vv[i * 64 + d]; }
            MIXM[n * DM_ + 512 + hh * 64 + d] = o / l; }
    }
    __syncthreads();
}

__device__ __forceinline__ void m2_item(const Args& A, LAS unsigned char* lds, int item, int tid) {
    tid = launder_v(tid);
    unsigned char* ws = A.ws; const float* MIXM = (const float*)(ws + WS_MIXM); float* H1M = (float*)(ws + WS_H1M);
    LAS float* red = (LAS float*)lds;
    const int c = tid & 15, ks = tid >> 4, col = 16 * item + c;
    { const float* wp = A.w_out + (size_t)(32 * ks) * DM_ + col; const float* mp = MIXM + 32 * ks;
      float w[32];
#pragma unroll
      for (int k = 0; k < 32; ++k) w[k] = wp[(size_t)k * DM_];
      float s0 = 0.f, s1 = 0.f;
#pragma unroll
      for (int k = 0; k < 32; ++k) { s0 += mp[k] * w[k]; s1 += mp[DM_ + k] * w[k]; }
      red[(ks * 2 + 0) * 16 + c] = s0; red[(ks * 2 + 1) * 16 + c] = s1; }
    __syncthreads();
    if (tid < 32) { const int n = tid >> 4, cc = tid & 15; float s = 0.f;
#pragma unroll
        for (int k = 0; k < 32; ++k) s += red[(k * 2 + n) * 16 + cc];
        H1M[n * DM_ + 16 * item + cc] = A.meta[(size_t)(14 + n) * DM_ + 16 * item + cc] + s; }
    __syncthreads();
}
__device__ __forceinline__ void m3_item(const Args& A, LAS unsigned char* lds, int item, int tid, int lane, int wave) {
    RELANE();
    unsigned char* ws = A.ws; const float* H1M = (const float*)(ws + WS_H1M); float* AM = (float*)(ws + WS_AMETA);
    LAS float* red = (LAS float*)lds; LAS float* part = red + 1024;
    { float a = 0.f; const int n = tid >> 8, k0 = (tid & 255) * 4;
      const f32x4 t = *(const f32x4*)(H1M + n * DM_ + k0); a = (t[0] * t[0] + t[1] * t[1]) + (t[2] * t[2] + t[3] * t[3]);
      a = wave_sum(a); if (lane == 0) part[wave] = a; }
    const int c = tid & 15, ks = tid >> 4, col = 16 * item + c;
    { const float* wp = A.w_up + (size_t)(32 * ks) * NUP + col; const float* hp = H1M + 32 * ks; const float* gp = A.ffn_g + 32 * ks;
      float w[32];
#pragma unroll
      for (int k = 0; k < 32; ++k) w[k] = wp[(size_t)k * NUP];
      float s0 = 0.f, s1 = 0.f;
#pragma unroll
      for (int k = 0; k < 32; ++k) { const float gw = gp[k] * w[k]; s0 += hp[k] * gw; s1 += hp[DM_ + k] * gw; }
      red[(ks * 2 + 0) * 16 + c] = s0; red[(ks * 2 + 1) * 16 + c] = s1; }
    __syncthreads();
    if (tid < 32) { const int n = tid >> 4, cc = tid & 15; float s = 0.f;
#pragma unroll
        for (int k = 0; k < 32; ++k) s += red[(k * 2 + n) * 16 + cc];
        const float rs = 1.0f / sqrtf(((part[4 * n] + part[4 * n + 1]) + (part[4 * n + 2] + part[4 * n + 3])) * (1.0f / DM_) + EPS_);
        AM[n * DFF + 16 * item + cc] = rs * s; }
    __syncthreads();
}

namespace ret {
constexpr int RS = 72;
constexpr int O_QR = 0, O_QW = 9216, O_KR = 18432, O_KWT = 27648, O_P = 36864, O_VT = 46080, O_RT = 64512, O_SS = 82944, LDS_USED = 83968;
__device__ __forceinline__ unsigned cvtpk(float lo, float hi) { typedef float f2 __attribute__((ext_vector_type(2))); typedef __bf16 b2 __attribute__((ext_vector_type(2))); f2 v = {lo, hi}; b2 b = __builtin_convertvector(v, b2); return __builtin_bit_cast(unsigned, b); }
__device__ __forceinline__ int crow(int r, int hi) { return (r & 3) + 8 * (r >> 2) + 4 * hi; }
__device__ __forceinline__ bf16x8v ldfrag(const LAS unsigned char* base, int row, int kel) { return *(const LAS bf16x8v*)(base + (row * RS + kel) * 2); }

__device__ __forceinline__ void item(const Args& A, LAS unsigned char* lds, int b, int h, int part, int tid, int lane, int wave) {
    RELANE();
    unsigned char* ws = A.ws;
    const bf16* PROJ = (const bf16*)(ws + WS_PROJ) + (size_t)(b * LP + 128) * NPROJ;
    const float* RC = (const float*)(ws + WS_ROPEC); const float* RSN = (const float*)(ws + WS_ROPES);
    bf16* MIX = (bf16*)(ws + WS_MIXED) + (size_t)b * FR * DM_ + h * 128;
    const float lg = log2f(1.0f - exp2f(-5.0f - (float)h));
    const float g64 = exp2f(lg * 64.0f);
    const int r32 = lane & 31, hi = lane >> 5;
    const int sn = tid >> 3, sj = (tid & 7) * 4;
    const int vm = (tid & 31) * 2, ve = (tid >> 5) * 8;
    const float wq = exp2f(lg * (float)(sn + 1)), wk = exp2f(lg * (float)(63 - sn));
    const int ob_e = wave & 3, ob_n = wave >> 2;
    const int rb_k = wave >> 2, rb_e = wave & 3;
    const int sb_m = wave & 1, sb_n = (wave >> 1) & 1;
    f32x16v R;
    { const float* um = (const float*)(ws + WS_UMETA) + (size_t)h * 8192;
#pragma unroll
      for (int r = 0; r < 16; ++r) R[r] = um[(32 * rb_k + crow(r, hi)) * 128 + 32 * rb_e + r32]; }
    float gv[16];
#pragma unroll
    for (int r = 0; r < 16; ++r) gv[r] = A.ret_g[h * 128 + 32 * ob_e + crow(r, hi)];
#define RET_PREFETCH(S, ci) do { const bf16* rowp = PROJ + (size_t)(64 * (ci) + sn) * NPROJ; \
        pq0_##S = *(const v2u*)(rowp + C_RQ + h * 64 + sj); pq1_##S = *(const v2u*)(rowp + C_RQ + h * 64 + 32 + sj); \
        pk0_##S = *(const v2u*)(rowp + C_RK + h * 64 + sj); pk1_##S = *(const v2u*)(rowp + C_RK + h * 64 + 32 + sj); \
        const bf16* vp = PROJ + (size_t)(64 * (ci) + vm) * NPROJ + C_RV + h * 128 + ve; pv0_##S = *(const v4u*)vp; pv1_##S = *(const v4u*)(vp + NPROJ); \
        const int pos = 128 + 64 * (ci) + sn; pc_##S = *(const f32x4*)(RC + pos * 32 + sj); ps_##S = *(const f32x4*)(RSN + pos * 32 + sj); } while (0)
#define RET_PREFETCH_KV(S, ci) do { const bf16* rowp = PROJ + (size_t)(64 * (ci) + sn) * NPROJ; \
        pk0_##S = *(const v2u*)(rowp + C_RK + h * 64 + sj); pk1_##S = *(const v2u*)(rowp + C_RK + h * 64 + 32 + sj); \
        const bf16* vp = PROJ + (size_t)(64 * (ci) + vm) * NPROJ + C_RV + h * 128 + ve; pv0_##S = *(const v4u*)vp; pv1_##S = *(const v4u*)(vp + NPROJ); \
        const int pos = 128 + 64 * (ci) + sn; pc_##S = *(const f32x4*)(RC + pos * 32 + sj); ps_##S = *(const f32x4*)(RSN + pos * 32 + sj); } while (0)
#define RET_PREFETCH_G(S, ci) do { const bf16* gp = PROJ + (size_t)(64 * (ci) + 32 * ob_n + r32) * NPROJ + C_RG + h * 128 + 32 * ob_e + 4 * hi; \
        _Pragma("unroll") for (int q = 0; q < 4; ++q) pg_##S[q] = *(const v2u*)(gp + 8 * q); } while (0)
#define RET_BAR() do { asm volatile("s_waitcnt lgkmcnt(0)" ::: "memory"); __builtin_amdgcn_s_barrier(); asm volatile("" ::: "memory"); } while (0)
    v2u pq0_A, pq1_A, pk0_A, pk1_A; v4u pv0_A, pv1_A; v2u pg_A[4]; f32x4 pc_A, ps_A;
    v2u pq0_B, pq1_B, pk0_B, pk1_B; v4u pv0_B, pv1_B; v2u pg_B[4]; f32x4 pc_B, ps_B;
    constexpr int XA = 32, XB = 52;
    const int c_begin = part == 0 ? 0 : (part == 1 ? XA : XB), c_end = part == 0 ? XA : (part == 1 ? XB : 64);
    if (part >= 1) {
        const int nkeep = (int)(40.0f / (-64.0f * lg)) + 2;
        const int c_s0 = (c_begin - nkeep > 0) ? ((c_begin - nkeep) & ~1) : 0;
        if (c_s0 > 0) {
#pragma unroll
            for (int r = 0; r < 16; ++r) R[r] = 0.f;
        }
        RET_PREFETCH_KV(A, c_s0); RET_PREFETCH_KV(B, c_s0 + 1);
#define RET_STATE_CHUNK(S, ci) do { \
            float k1[4], k2[4]; \
            k1[0] = __uint_as_float(pk0_##S[0] << 16); k1[1] = __uint_as_float(pk0_##S[0] & 0xffff0000u); k1[2] = __uint_as_float(pk0_##S[1] << 16); k1[3] = __uint_as_float(pk0_##S[1] & 0xffff0000u); \
            k2[0] = __uint_as_float(pk1_##S[0] << 16); k2[1] = __uint_as_float(pk1_##S[0] & 0xffff0000u); k2[2] = __uint_as_float(pk1_##S[1] << 16); k2[3] = __uint_as_float(pk1_##S[1] & 0xffff0000u); \
            float ka[4], kb[4]; \
            _Pragma("unroll") for (int i = 0; i < 4; ++i) { ka[i] = (k1[i] * pc_##S[i] - k2[i] * ps_##S[i]) * (0.125f * wk); kb[i] = (k1[i] * ps_##S[i] + k2[i] * pc_##S[i]) * (0.125f * wk); } \
            _Pragma("unroll") for (int i = 0; i < 4; i += 2) { const unsigned wa = cvtpk(ka[i], ka[i + 1]), wb = cvtpk(kb[i], kb[i + 1]); \
                *(LAS unsigned short*)(lds + O_KWT + ((sj + i) * RS + sn) * 2) = (unsigned short)wa; *(LAS unsigned short*)(lds + O_KWT + ((sj + i + 1) * RS + sn) * 2) = (unsigned short)(wa >> 16); \
                *(LAS unsigned short*)(lds + O_KWT + ((32 + sj + i) * RS + sn) * 2) = (unsigned short)wb; *(LAS unsigned short*)(lds + O_KWT + ((32 + sj + i + 1) * RS + sn) * 2) = (unsigned short)(wb >> 16); } \
            _Pragma("unroll") for (int i = 0; i < 4; ++i) { const unsigned a = pv0_##S[i], c = pv1_##S[i]; \
                *(LAS unsigned*)(lds + O_VT + ((ve + 2 * i) * RS + vm) * 2) = (a & 0xffffu) | (c << 16); \
                *(LAS unsigned*)(lds + O_VT + ((ve + 2 * i + 1) * RS + vm) * 2) = (a >> 16) | (c & 0xffff0000u); } \
            RET_BAR(); \
            if ((ci) + 2 < c_begin) RET_PREFETCH_KV(S, (ci) + 2); \
            _Pragma("unroll") for (int r = 0; r < 16; ++r) R[r] *= g64; \
            _Pragma("unroll") for (int ks = 0; ks < 4; ++ks) R = __builtin_amdgcn_mfma_f32_32x32x16_bf16(ldfrag(lds + O_KWT, 32 * rb_k + r32, 16 * ks + 8 * hi), ldfrag(lds + O_VT, 32 * rb_e + r32, 16 * ks + 8 * hi), R, 0, 0, 0); \
            RET_BAR(); } while (0)
        for (int c2 = c_s0; c2 < c_begin; c2 += 2) { RET_STATE_CHUNK(A, c2); RET_STATE_CHUNK(B, c2 + 1); }
#undef RET_STATE_CHUNK
    }
    RET_PREFETCH(A, c_begin); RET_PREFETCH(B, c_begin + 1); RET_PREFETCH_G(A, c_begin); RET_PREFETCH_G(B, c_begin + 1);
    for (int c2 = c_begin; c2 < c_end; c2 += 2) {
      { const int ci = c2;
        {
            float q1[4], q2[4], k1[4], k2[4];
            q1[0] = __uint_as_float(pq0_A[0] << 16); q1[1] = __uint_as_float(pq0_A[0] & 0xffff0000u); q1[2] = __uint_as_float(pq0_A[1] << 16); q1[3] = __uint_as_float(pq0_A[1] & 0xffff0000u);
            q2[0] = __uint_as_float(pq1_A[0] << 16); q2[1] = __uint_as_float(pq1_A[0] & 0xffff0000u); q2[2] = __uint_as_float(pq1_A[1] << 16); q2[3] = __uint_as_float(pq1_A[1] & 0xffff0000u);
            k1[0] = __uint_as_float(pk0_A[0] << 16); k1[1] = __uint_as_float(pk0_A[0] & 0xffff0000u); k1[2] = __uint_as_float(pk0_A[1] << 16); k1[3] = __uint_as_float(pk0_A[1] & 0xffff0000u);
            k2[0] = __uint_as_float(pk1_A[0] << 16); k2[1] = __uint_as_float(pk1_A[0] & 0xffff0000u); k2[2] = __uint_as_float(pk1_A[1] << 16); k2[3] = __uint_as_float(pk1_A[1] & 0xffff0000u);
            float qa[4], qb[4], ka[4], kb[4];
#pragma unroll
            for (int i = 0; i < 4; ++i) { qa[i] = q1[i] * pc_A[i] - q2[i] * ps_A[i]; qb[i] = q1[i] * ps_A[i] + q2[i] * pc_A[i];
                ka[i] = (k1[i] * pc_A[i] - k2[i] * ps_A[i]) * 0.125f; kb[i] = (k1[i] * ps_A[i] + k2[i] * pc_A[i]) * 0.125f; }
            *(LAS v2u*)(lds + O_QR + (sn * RS + sj) * 2) = (v2u){cvtpk(qa[0], qa[1]), cvtpk(qa[2], qa[3])};
            *(LAS v2u*)(lds + O_QR + (sn * RS + 32 + sj) * 2) = (v2u){cvtpk(qb[0], qb[1]), cvtpk(qb[2], qb[3])};
            *(LAS v2u*)(lds + O_QW + (sn * RS + sj) * 2) = (v2u){cvtpk(qa[0] * wq, qa[1] * wq), cvtpk(qa[2] * wq, qa[3] * wq)};
            *(LAS v2u*)(lds + O_QW + (sn * RS + 32 + sj) * 2) = (v2u){cvtpk(qb[0] * wq, qb[1] * wq), cvtpk(qb[2] * wq, qb[3] * wq)};
            *(LAS v2u*)(lds + O_KR + (sn * RS + sj) * 2) = (v2u){cvtpk(ka[0], ka[1]), cvtpk(ka[2], ka[3])};
            *(LAS v2u*)(lds + O_KR + (sn * RS + 32 + sj) * 2) = (v2u){cvtpk(kb[0], kb[1]), cvtpk(kb[2], kb[3])};
#pragma unroll
            for (int i = 0; i < 4; i += 2) { const unsigned wa = cvtpk(ka[i] * wk, ka[i + 1] * wk), wb = cvtpk(kb[i] * wk, kb[i + 1] * wk);
                *(LAS unsigned short*)(lds + O_KWT + ((sj + i) * RS + sn) * 2) = (unsigned short)wa; *(LAS unsigned short*)(lds + O_KWT + ((sj + i + 1) * RS + sn) * 2) = (unsigned short)(wa >> 16);
                *(LAS unsigned short*)(lds + O_KWT + ((32 + sj + i) * RS + sn) * 2) = (unsigned short)wb; *(LAS unsigned short*)(lds + O_KWT + ((32 + sj + i + 1) * RS + sn) * 2) = (unsigned short)(wb >> 16); }
#pragma unroll
            for (int i = 0; i < 4; ++i) { const unsigned a = pv0_A[i], c = pv1_A[i];
                *(LAS unsigned*)(lds + O_VT + ((ve + 2 * i) * RS + vm) * 2) = (a & 0xffffu) | (c << 16);
                *(LAS unsigned*)(lds + O_VT + ((ve + 2 * i + 1) * RS + vm) * 2) = (a >> 16) | (c & 0xffff0000u); }
#pragma unroll
            for (int g = 0; g < 4; ++g) *(LAS v2u*)(lds + O_RT + ((32 * rb_e + r32) * RS + 32 * rb_k + 8 * g + 4 * hi) * 2) = (v2u){cvtpk(R[4 * g], R[4 * g + 1]), cvtpk(R[4 * g + 2], R[4 * g + 3])};
        }
        RET_BAR();
        if (ci + 2 < c_end) RET_PREFETCH(A, ci + 2);
        if (wave < 4) {
            f32x16v s = {};
#pragma unroll
            for (int ks = 0; ks < 4; ++ks) s = __builtin_amdgcn_mfma_f32_32x32x16_bf16(ldfrag(lds + O_KR, 32 * sb_m + r32, 16 * ks + 8 * hi), ldfrag(lds + O_QR, 32 * sb_n + r32, 16 * ks + 8 * hi), s, 0, 0, 0);
            const int n = 32 * sb_n + r32;
#pragma unroll
            for (int g = 0; g < 4; ++g) { float pvv[4];
#pragma unroll
                for (int i = 0; i < 4; ++i) { const int m = 32 * sb_m + 8 * g + 4 * hi + i; pvv[i] = s[4 * g + i] * __builtin_amdgcn_exp2f(lg * fabsf((float)(n - m))); }
                *(LAS v2u*)(lds + O_P + (n * RS + 32 * sb_m + 8 * g + 4 * hi) * 2) = (v2u){cvtpk(pvv[0], pvv[1]), cvtpk(pvv[2], pvv[3])}; }
        }
        f32x16v o = {};
#pragma unroll
        for (int ks = 0; ks < 4; ++ks) o = __builtin_amdgcn_mfma_f32_32x32x16_bf16(ldfrag(lds + O_RT, 32 * ob_e + r32, 16 * ks + 8 * hi), ldfrag(lds + O_QW, 32 * ob_n + r32, 16 * ks + 8 * hi), o, 0, 0, 0);
#pragma unroll
        for (int r = 0; r < 16; ++r) R[r] *= g64;
#pragma unroll
        for (int ks = 0; ks < 4; ++ks) R = __builtin_amdgcn_mfma_f32_32x32x16_bf16(ldfrag(lds + O_KWT, 32 * rb_k + r32, 16 * ks + 8 * hi), ldfrag(lds + O_VT, 32 * rb_e + r32, 16 * ks + 8 * hi), R, 0, 0, 0);
        RET_BAR();
#pragma unroll
        for (int ks = 0; ks < 4; ++ks) o = __builtin_amdgcn_mfma_f32_32x32x16_bf16(ldfrag(lds + O_VT, 32 * ob_e + r32, 16 * ks + 8 * hi), ldfrag(lds + O_P, 32 * ob_n + r32, 16 * ks + 8 * hi), o, 0, 0, 0);
        { float ss = 0.f;
#pragma unroll
          for (int r = 0; r < 16; ++r) ss += o[r] * o[r];
          ss += __shfl_xor(ss, 32);
          if (hi == 0) *(LAS float*)(lds + O_SS + ((32 * ob_n + r32) * 4 + ob_e) * 4) = ss; }
        RET_BAR();
        { const f32x4 p4 = *(const LAS f32x4*)(lds + O_SS + (32 * ob_n + r32) * 16);
          const float rs = __builtin_amdgcn_rsqf(((p4[0] + p4[1]) + (p4[2] + p4[3])) * (1.0f / 128.0f) + EPS_);
          bf16* op = MIX + (size_t)(64 * ci + 32 * ob_n + r32) * DM_ + 32 * ob_e + 4 * hi;
#pragma unroll
          for (int g = 0; g < 4; ++g) { float y[4]; float zz[4];
              zz[0] = __uint_as_float(pg_A[g][0] << 16); zz[1] = __uint_as_float(pg_A[g][0] & 0xffff0000u); zz[2] = __uint_as_float(pg_A[g][1] << 16); zz[3] = __uint_as_float(pg_A[g][1] & 0xffff0000u);
#pragma unroll
              for (int i = 0; i < 4; ++i) { const float z = zz[i]; y[i] = o[4 * g + i] * rs * gv[4 * g + i] * z * __builtin_amdgcn_rcpf(1.0f + __expf(-z)); }
              *(v2u*)(op + 8 * g) = (v2u){cvtpk(y[0], y[1]), cvtpk(y[2], y[3])}; } }
        if (ci + 2 < c_end) RET_PREFETCH_G(A, ci + 2);
          }
      { const int ci = c2 + 1;
        {
            float q1[4], q2[4], k1[4], k2[4];
            q1[0] = __uint_as_float(pq0_B[0] << 16); q1[1] = __uint_as_float(pq0_B[0] & 0xffff0000u); q1[2] = __uint_as_float(pq0_B[1] << 16); q1[3] = __uint_as_float(pq0_B[1] & 0xffff0000u);
            q2[0] = __uint_as_float(pq1_B[0] << 16); q2[1] = __uint_as_float(pq1_B[0] & 0xffff0000u); q2[2] = __uint_as_float(pq1_B[1] << 16); q2[3] = __uint_as_float(pq1_B[1] & 0xffff0000u);
            k1[0] = __uint_as_float(pk0_B[0] << 16); k1[1] = __uint_as_float(pk0_B[0] & 0xffff0000u); k1[2] = __uint_as_float(pk0_B[1] << 16); k1[3] = __uint_as_float(pk0_B[1] & 0xffff0000u);
            k2[0] = __uint_as_float(pk1_B[0] << 16); k2[1] = __uint_as_float(pk1_B[0] & 0xffff0000u); k2[2] = __uint_as_float(pk1_B[1] << 16); k2[3] = __uint_as_float(pk1_B[1] & 0xffff0000u);
            float qa[4], qb[4], ka[4], kb[4];
#pragma unroll
            for (int i = 0; i < 4; ++i) { qa[i] = q1[i] * pc_B[i] - q2[i] * ps_B[i]; qb[i] = q1[i] * ps_B[i] + q2[i] * pc_B[i];
                ka[i] = (k1[i] * pc_B[i] - k2[i] * ps_B[i]) * 0.125f; kb[i] = (k1[i] * ps_B[i] + k2[i] * pc_B[i]) * 0.125f; }
            *(LAS v2u*)(lds + O_QR + (sn * RS + sj) * 2) = (v2u){cvtpk(qa[0], qa[1]), cvtpk(qa[2], qa[3])};
            *(LAS v2u*)(lds + O_QR + (sn * RS + 32 + sj) * 2) = (v2u){cvtpk(qb[0], qb[1]), cvtpk(qb[2], qb[3])};
            *(LAS v2u*)(lds + O_QW + (sn * RS + sj) * 2) = (v2u){cvtpk(qa[0] * wq, qa[1] * wq), cvtpk(qa[2] * wq, qa[3] * wq)};
            *(LAS v2u*)(lds + O_QW + (sn * RS + 32 + sj) * 2) = (v2u){cvtpk(qb[0] * wq, qb[1] * wq), cvtpk(qb[2] * wq, qb[3] * wq)};
            *(LAS v2u*)(lds + O_KR + (sn * RS + sj) * 2) = (v2u){cvtpk(ka[0], ka[1]), cvtpk(ka[2], ka[3])};
            *(LAS v2u*)(lds + O_KR + (sn * RS + 32 + sj) * 2) = (v2u){cvtpk(kb[0], kb[1]), cvtpk(kb[2], kb[3])};
#pragma unroll
            for (int i = 0; i < 4; i += 2) { const unsigned wa = cvtpk(ka[i] * wk, ka[i + 1] * wk), wb = cvtpk(kb[i] * wk, kb[i + 1] * wk);
                *(LAS unsigned short*)(lds + O_KWT + ((sj + i) * RS + sn) * 2) = (unsigned short)wa; *(LAS unsigned short*)(lds + O_KWT + ((sj + i + 1) * RS + sn) * 2) = (unsigned short)(wa >> 16);
                *(LAS unsigned short*)(lds + O_KWT + ((32 + sj + i) * RS + sn) * 2) = (unsigned short)wb; *(LAS unsigned short*)(lds + O_KWT + ((32 + sj + i + 1) * RS + sn) * 2) = (unsigned short)(wb >> 16); }
#pragma unroll
            for (int i = 0; i < 4; ++i) { const unsigned a = pv0_B[i], c = pv1_B[i];
                *(LAS unsigned*)(lds + O_VT + ((ve + 2 * i) * RS + vm) * 2) = (a & 0xffffu) | (c << 16);
                *(LAS unsigned*)(lds + O_VT + ((ve + 2 * i + 1) * RS + vm) * 2) = (a >> 16) | (c & 0xffff0000u); }
#pragma unroll
            for (int g = 0; g < 4; ++g) *(LAS v2u*)(lds + O_RT + ((32 * rb_e + r32) * RS + 32 * rb_k + 8 * g + 4 * hi) * 2) = (v2u){cvtpk(R[4 * g], R[4 * g + 1]), cvtpk(R[4 * g + 2], R[4 * g + 3])};
        }
        RET_BAR();
        if (ci + 2 < c_end) RET_PREFETCH(B, ci + 2);
        if (wave < 4) {
            f32x16v s = {};
#pragma unroll
            for (int ks = 0; ks < 4; ++ks) s = __builtin_amdgcn_mfma_f32_32x32x16_bf16(ldfrag(lds + O_KR, 32 * sb_m + r32, 16 * ks + 8 * hi), ldfrag(lds + O_QR, 32 * sb_n + r32, 16 * ks + 8 * hi), s, 0, 0, 0);
            const int n = 32 * sb_n + r32;
#pragma unroll
            for (int g = 0; g < 4; ++g) { float pvv[4];
#pragma unroll
                for (int i = 0; i < 4; ++i) { const int m = 32 * sb_m + 8 * g + 4 * hi + i; pvv[i] = s[4 * g + i] * __builtin_amdgcn_exp2f(lg * fabsf((float)(n - m))); }
                *(LAS v2u*)(lds + O_P + (n * RS + 32 * sb_m + 8 * g + 4 * hi) * 2) = (v2u){cvtpk(pvv[0], pvv[1]), cvtpk(pvv[2], pvv[3])}; }
        }
        f32x16v o = {};
#pragma unroll
        for (int ks = 0; ks < 4; ++ks) o = __builtin_amdgcn_mfma_f32_32x32x16_bf16(ldfrag(lds + O_RT, 32 * ob_e + r32, 16 * ks + 8 * hi), ldfrag(lds + O_QW, 32 * ob_n + r32, 16 * ks + 8 * hi), o, 0, 0, 0);
#pragma unroll
        for (int r = 0; r < 16; ++r) R[r] *= g64;
#pragma unroll
        for (int ks = 0; ks < 4; ++ks) R = __builtin_amdgcn_mfma_f32_32x32x16_bf16(ldfrag(lds + O_KWT, 32 * rb_k + r32, 16 * ks + 8 * hi), ldfrag(lds + O_VT, 32 * rb_e + r32, 16 * ks + 8 * hi), R, 0, 0, 0);
        RET_BAR();
#pragma unroll
        for (int ks = 0; ks < 4; ++ks) o = __builtin_amdgcn_mfma_f32_32x32x16_bf16(ldfrag(lds + O_VT, 32 * ob_e + r32, 16 * ks + 8 * hi), ldfrag(lds + O_P, 32 * ob_n + r32, 16 * ks + 8 * hi), o, 0, 0, 0);
        { float ss = 0.f;
#pragma unroll
          for (int r = 0; r < 16; ++r) ss += o[r] * o[r];
          ss += __shfl_xor(ss, 32);
          if (hi == 0) *(LAS float*)(lds + O_SS + ((32 * ob_n + r32) * 4 + ob_e) * 4) = ss; }
        RET_BAR();
        { const f32x4 p4 = *(const LAS f32x4*)(lds + O_SS + (32 * ob_n + r32) * 16);
          const float rs = __builtin_amdgcn_rsqf(((p4[0] + p4[1]) + (p4[2] + p4[3])) * (1.0f / 128.0f) + EPS_);
          bf16* op = MIX + (size_t)(64 * ci + 32 * ob_n + r32) * DM_ + 32 * ob_e + 4 * hi;
#pragma unroll
          for (int g = 0; g < 4; ++g) { float y[4]; float zz[4];
              zz[0] = __uint_as_float(pg_B[g][0] << 16); zz[1] = __uint_as_float(pg_B[g][0] & 0xffff0000u); zz[2] = __uint_as_float(pg_B[g][1] << 16); zz[3] = __uint_as_float(pg_B[g][1] & 0xffff0000u);
#pragma unroll
              for (int i = 0; i < 4; ++i) { const float z = zz[i]; y[i] = o[4 * g + i] * rs * gv[4 * g + i] * z * __builtin_amdgcn_rcpf(1.0f + __expf(-z)); }
              *(v2u*)(op + 8 * g) = (v2u){cvtpk(y[0], y[1]), cvtpk(y[2], y[3])}; } }
        if (ci + 2 < c_end) RET_PREFETCH_G(B, ci + 2);
          }
    }
#undef RET_PREFETCH
#undef RET_PREFETCH_G
#undef RET_PREFETCH_KV
#undef RET_BAR
    __syncthreads();
}
}

__device__ __forceinline__ void fixup_phase(const Args& A, int vcu, int G, int tid) {
    tid = launder_v(tid);
    unsigned char* ws = A.ws; const float* AT = (const float*)(ws + WS_ATAIL); const float* AH = (const float*)(ws + WS_AHEAD); const float* BH = (const float*)(ws + WS_BHEAD); const float* AM = (const float*)(ws + WS_AMETA);
    bf16* Gm = (bf16*)(ws + WS_G);
    const int NIT = 512 * 2 * (DFF / 8);
    for (int it = vcu * NTHR + tid; it < NIT; it += G * NTHR) {
        const int cg8 = it % (DFF / 8), sr = it / (DFF / 8), sidx = sr >> 1, j = sr & 1, f0 = 8 * cg8;
        const float* pm2; const float* pm1;
        const float* t0 = (sidx & 63) ? AT + (size_t)((sidx - 1) * 2) * DFF : AM;
        const float* h0 = AH + (size_t)(sidx * 2) * DFF;
        if (j == 0) { pm2 = t0; pm1 = t0 + DFF; } else { pm2 = t0 + DFF; pm1 = h0; }
        const float* pa = h0 + (size_t)j * DFF; const float* pb = BH + (size_t)(sidx * 2 + j) * DFF;
        float g[8];
#pragma unroll
        for (int c = 0; c < 8; ++c) { const int f = f0 + c;
            const float z = A.conv_b[f] + A.conv_w[f] * pm2[f] + A.conv_w[DFF + f] * pm1[f] + A.conv_w[2 * DFF + f] * pa[f];
            g[c] = z * pb[f] / (1.0f + __expf(-z)); }
        *(v4u*)(Gm + (size_t)(sidx * 64 + j) * DFF + f0) = (v4u){pk2(g[0], g[1]), pk2(g[2], g[3]), pk2(g[4], g[5]), pk2(g[6], g[7])};
    }
}

__device__ __forceinline__ void final_norm_phase(const Args& A, int vcu, int G, int lane, int wave) {
    { int tid = launder_v((int)threadIdx.x); lane = tid & 63; wave = __builtin_amdgcn_readfirstlane(tid >> 6); }
    const float* ss2 = (const float*)(A.ws + WS_ROWSS2);
    f32x4 gk[4];
#pragma unroll
    for (int j = 0; j < 4; ++j) gk[j] = *(const f32x4*)(A.final_g + 4 * lane + 256 * j);
    for (int m = vcu * NWAVES + wave; m < MROWS; m += G * NWAVES) {
        GAS f32x4* p = (GAS f32x4*)(A.out + (size_t)m * DM_) + lane;
        const float rs = 1.0f / sqrtf(ss2[m] * (1.0f / DM_) + EPS_);
#pragma unroll
        for (int j = 0; j < 4; ++j) { f32x4 v = p[64 * j]; p[64 * j] = v * rs * gk[j]; }
    }
}

#define FB_WORD(s, j) (CW_FB + ((s) * 17 + (j)) * 64)
__device__ __forceinline__ unsigned fb_xcc_id() { return (unsigned)__builtin_amdgcn_s_getreg((3 << 11) | 20) & 0xFu; }
struct FBar { unsigned* ctl; volatile LAS unsigned* st; unsigned x; };
__device__ __forceinline__ void fbar_census(const FBar& b) {
    if (threadIdx.x == 0) { unsigned mine = 0u, cnt = 0u, sum = 0u, sp = 0u; const unsigned G = gridDim.x;
        for (;;) { mine = 0u; cnt = 0u; sum = 0u;
            for (unsigned j = 0; j < 16; ++j) { const unsigned c = __hip_atomic_load(b.ctl + CW_CENSUS + 64 * j, __ATOMIC_RELAXED, __HIP_MEMORY_SCOPE_AGENT); sum += c; cnt += (c > 0u) ? 1u : 0u; mine = (j == b.x) ? c : mine; }
            if (sum == G || ++sp > (1u << 20)) break;
            __builtin_amdgcn_s_sleep(1); }
        b.st[0] = mine > 0u ? mine : 1u; b.st[1] = cnt > 0u ? cnt : 1u; }
    __syncthreads();
}
template <bool FENCE = true> __device__ __forceinline__ void fbar(const FBar& b, int seam) {
    asm volatile("s_waitcnt vmcnt(0)" ::: "memory");
    __syncthreads();
    if (threadIdx.x == 0) {
        const unsigned nloc = b.st[0], nx = b.st[1];
        unsigned* top = b.ctl + FB_WORD(seam, 16);
        const unsigned old = __hip_atomic_fetch_add(b.ctl + FB_WORD(seam, b.x), 1u, __ATOMIC_RELAXED, __HIP_MEMORY_SCOPE_AGENT);
        if (old + 1u == nloc) {
            if (FENCE) { __builtin_amdgcn_fence(__ATOMIC_RELEASE, "agent"); asm volatile("s_waitcnt vmcnt(0)" ::: "memory"); }
            __hip_atomic_fetch_add(top, 1u, __ATOMIC_RELAXED, __HIP_MEMORY_SCOPE_AGENT);
        }
        unsigned sp = 0u;
        while (__hip_atomic_load(top, __ATOMIC_RELAXED, __HIP_MEMORY_SCOPE_AGENT) < nx && ++sp < (1u << 20)) __builtin_amdgcn_s_sleep(1);
        if (FENCE) { __builtin_amdgcn_fence(__ATOMIC_ACQUIRE, "agent"); asm volatile("s_waitcnt vmcnt(0)" ::: "memory"); }
    }
    __syncthreads();
}
constexpr int Q_RET = 96, Q_ATT = 1024, Q_M2 = 64, Q_TOTAL = Q_RET + Q_ATT + Q_M2;

__global__ void __launch_bounds__(NTHR, 2) hymba_fwd(Args args) {
    extern __shared__ __attribute__((aligned(16))) unsigned char lds_raw[];
    LAS unsigned char* lds = (LAS unsigned char*)lds_raw;
    cg::grid_group grid = cg::this_grid();
    const int tid = threadIdx.x, lane = tid & 63, wave = __builtin_amdgcn_readfirstlane(tid >> 6);
    const int G = gridDim.x, bid = blockIdx.x;
    const int vcu = (G % 8 == 0) ? (bid % 8) * (G / 8) + bid / 8 : bid;
    unsigned char* ws = args.ws;
    volatile LAS unsigned* MISC = (volatile LAS unsigned*)(lds + LDSCTL_OFF);
    if (tid < 64) MISC[tid] = 0u;
    __syncthreads();
    FBar bar; bar.ctl = (unsigned*)(ws + WS_CTL); bar.st = MISC + 8; bar.x = fb_xcc_id();
    for (int i = bid * NTHR + tid; i < (int)(CTL_ZERO_BYTES / 4); i += G * NTHR) bar.ctl[i] = 0u;
    int seam_no = 0;
#define SEAM() do { fbar(bar, seam_no); ++seam_no; } while (0)
    grid.sync();
    if (tid == 0) __hip_atomic_fetch_add(bar.ctl + CW_CENSUS + 64 * bar.x, 1u, __ATOMIC_RELAXED, __HIP_MEMORY_SCOPE_AGENT);

#ifndef SKIP_P0
    p0_prologue(args, lds, vcu, G, tid, lane, wave);
#endif
    fbar_census(bar);
    SEAM();
#ifdef DUP_P0
    p0_prologue(args, lds, vcu, G, tid, lane, wave);
    SEAM();
#endif
#ifdef DUP_SYNC
    for (int i_ = 0; i_ < 8; ++i_) SEAM();
#endif
#ifdef DUP_SYNC_NF
    for (int i_ = 0; i_ < 8; ++i_) { fbar<false>(bar, seam_no); ++seam_no; }
#endif

    {
    if (bid < 64 && wave == 0) cumsum_item(args, bid, lane);
#ifndef SKIP_M1
    if (bid >= G - 12) m1_item(args, lds, G - 1 - bid, tid, lane, wave);
#endif
    __syncthreads();
    {
        pg8::Gemm g{(const pg8::bf16_t*)(ws + WS_XN), (const pg8::bf16_t*)(ws + WS_WIN), MROWS, NPROJ, DM_}; pg8::StaticOrder S; S.init(MROWS, NPROJ, G, bid);
        pg8::EpiProj E{(pg8::bf16_t*)(ws + WS_PROJ), NPROJ, (unsigned*)(ws + WS_CTL) + CW_NORMS};
#ifndef SKIP_G1
        pg8::gemm_phase<pg8::EpiProj, pg8::StaticOrder, true, true>(lds, g, S, E);
#endif
#ifdef DUP_P1
        SEAM();
        pg8::gemm_phase<pg8::EpiProj, pg8::StaticOrder, true, true>(lds, g, S, E);
#endif
    }
    SEAM();
    }

    {
#ifdef DUP_P2
      for (int rep_ = 0; rep_ < 2; ++rep_) {
        unsigned* ctr = (unsigned*)(ws + WS_CTL) + rep_;
#else
      {
        unsigned* ctr = (unsigned*)(ws + WS_CTL);
#endif
        unsigned qnext = 0u; bool have_next = false;
        for (;;) {
            if (have_next) { if (tid == 0) MISC[0] = qnext; __syncthreads(); }
            else { __syncthreads(); if (tid == 0) MISC[0] = atomicAdd(ctr, 1u); __syncthreads(); }
            have_next = false;
            const int it = __builtin_amdgcn_readfirstlane((int)MISC[0]);
            if (it >= Q_TOTAL) break;
            if (it < Q_RET) {
#ifndef SKIP_RET
                ret::item(args, lds, (it & 31) >> 2, it & 3, 2 - (it >> 5), tid, lane, wave);
#endif
            }
            else if (it < Q_RET + Q_ATT) { const int a = it - Q_RET, qb = 15 - (a >> 6), bh = a & 63;
                const attn_body::bf16* P = (const attn_body::bf16*)(ws + WS_PROJ); (void)P; (void)qb; (void)bh;
#ifndef SKIP_ATT
                int t0;
                { const unsigned* nq = (const unsigned*)(ws + WS_CTL) + CW_NORMS + bh * 6; const float* bs = (const float*)(ws + WS_BIAS) + (size_t)bh * LP;
                  const int q0 = 128 + 256 * qb, ntm4 = (q0 + 256) / 64 - 4, ln = launder_v(lane);
                  const float bq = bs[q0], bk = bs[64 * ((ln < ntm4) ? ln : 0) + 63];
                  const float q2 = __uint_as_float(nq[0]) + __uint_as_float(nq[1]), k2 = fmaxf(__uint_as_float(nq[2]) + __uint_as_float(nq[3]), __uint_as_float(nq[4]));
                  const float thresh = 2.1f * sqrtf(q2 * k2) + 40.0f;
                  const unsigned long long skip = __ballot((ln < ntm4) && (bq - bk >= thresh));
                  const int cnt = __builtin_amdgcn_readfirstlane((int)__builtin_ctzll(~skip));
                  t0 = (cnt < ntm4 ? cnt : ntm4) & ~1; }
                attn_body::attn_unit<30>(bh >> 3, bh & 7, qb, P + C_FQ, P + C_FK, P + C_FV, (attn_body::bf16*)(ws + WS_MIXED), (const float*)(ws + WS_BIAS), t0, ctr, qnext, (char*)lds_raw);
                have_next = true;
#endif
            }
            else m2_item(args, lds, it - Q_RET - Q_ATT, tid);
        }
#ifdef DUP_RET
        __syncthreads();
        if (bid < 64) ret::item(args, lds, (bid & 31) >> 2, bid & 3, (bid < 32) ? 1 : 0, tid, lane, wave);
#endif
#ifdef DUP_ATT
        __syncthreads();
        for (int i_ = 0; i_ < 4; ++i_) { const int a = bid * 4 + i_, qb = ((i_ & 1) ? 15 - (a >> 6) : (a >> 6)), bh = a & 63;
            const attn_body::bf16* P = (const attn_body::bf16*)(ws + WS_PROJ);
            attn_body::attn_unit<8>(bh >> 3, bh & 7, qb, P + C_FQ, P + C_FK, P + C_FV, (attn_body::bf16*)(ws + WS_MIXED), (const float*)(ws + WS_BIAS), 0, ctr + 8, qnext, (char*)lds_raw); }
#endif
#ifdef DUP_P2
        SEAM();
#endif
      }
    }
#ifndef DUP_P2
    SEAM();
#endif

    if (bid < 176) m3_item(args, lds, bid, tid, lane, wave);
    __syncthreads();
    {
        pg8::Gemm g{(const pg8::bf16_t*)(ws + WS_MIXED), (const pg8::bf16_t*)(ws + WS_WOUT), MROWS, DM_, DM_}; pg8::StaticOrder S; S.init(MROWS, DM_, G, bid);
        pg8::EpiRes1 E{args.x, (pg8::bf16_t*)(ws + WS_H1), (float*)(ws + WS_ROWSS), DM_};
#ifndef SKIP_G3
        pg8::gemm_phase<pg8::EpiRes1, pg8::StaticOrder, true, true>(lds, g, S, E);
#endif
#ifdef DUP_P3
        SEAM();
        { pg8::EpiRes1 E2{args.x, (pg8::bf16_t*)(ws + WS_H1), nullptr, DM_}; pg8::gemm_phase<pg8::EpiRes1, pg8::StaticOrder, true, true>(lds, g, S, E2); }
#endif
    }
    SEAM();

#ifdef DUP_P4
    for (int rep_ = 0; rep_ < 2; ++rep_)
#endif
    {
    {
        pg8::Gemm g{(const pg8::bf16_t*)(ws + WS_H1), (const pg8::bf16_t*)(ws + WS_WUP), MROWS, NUP, DM_}; pg8::StaticOrder S; S.init(MROWS, NUP, G, bid);
        pg8::EpiUp E{(pg8::bf16_t*)(ws + WS_G), (const float*)(ws + WS_ROWSS), args.conv_w, args.conv_b, (float*)(ws + WS_ATAIL), (float*)(ws + WS_AHEAD), (float*)(ws + WS_BHEAD)};
#ifndef SKIP_G4
        pg8::gemm_phase<pg8::EpiUp, pg8::StaticOrder, true, true>(lds, g, S, E);
#endif
    }
    SEAM();
    }
    fixup_phase(args, vcu, G, tid);
    SEAM();

    {
        pg8::Gemm g{(const pg8::bf16_t*)(ws + WS_G), (const pg8::bf16_t*)(ws + WS_WDN), MROWS, DM_, DFF}; pg8::StaticOrder S; S.init(MROWS, DM_, G, bid);
#ifdef DUP_P5
        { pg8::EpiRes1 E2{args.x, (pg8::bf16_t*)(ws + WS_XN), nullptr, DM_}; pg8::gemm_phase<pg8::EpiRes1, pg8::StaticOrder, true, true>(lds, g, S, E2); }
        SEAM();
#endif
#ifndef SKIP_G5
        if (G == 256) {
            pg8::EpiRes2N E{(const pg8::bf16_t*)(ws + WS_H1), args.out, (float*)(ws + WS_ROWSS2), (unsigned*)(ws + WS_CTL) + CW_PANEL, args.final_g, DM_};
            pg8::gemm_phase<pg8::EpiRes2N, pg8::StaticOrder, true, true>(lds, g, S, E);
        } else {
            pg8::EpiRes2 E{(const pg8::bf16_t*)(ws + WS_H1), args.out, (float*)(ws + WS_ROWSS2), DM_};
            pg8::gemm_phase<pg8::EpiRes2, pg8::StaticOrder, true, true>(lds, g, S, E);
        }
#endif
    }
    if (G != 256) {
        SEAM();
        final_norm_phase(args, vcu, G, lane, wave);
    }
}

extern "C" void kernel_launch(void* const* d_in, const int* in_sizes, int n_in, void* d_out, int out_size, void* d_ws, size_t ws_size, hipStream_t stream) {
    static int grid = 0;
    if (grid == 0) {
        if (n_in != 13 || in_sizes[0] != MROWS * DM_ || out_size != MROWS * DM_ || ws_size < WS_END) {
            fprintf(stderr, "kernel_launch: unexpected shapes (n_in %d, in0 %d, out %d, ws %zu); nothing launched\n", n_in, n_in > 0 ? in_sizes[0] : -1, out_size, ws_size); grid = -1; return; }
        int dev = 0, cus = 0, per_cu = 0;
        hipGetDevice(&dev); hipDeviceGetAttribute(&cus, hipDeviceAttributeMultiprocessorCount, dev);
        if (hipFuncSetAttribute((const void*)hymba_fwd, hipFuncAttributeMaxDynamicSharedMemorySize, LDS_BYTES) != hipSuccess) { fprintf(stderr, "kernel_launch: hipFuncSetAttribute failed\n"); grid = -1; return; }
        if (hipOccupancyMaxActiveBlocksPerMultiprocessor(&per_cu, (const void*)hymba_fwd, NTHR, LDS_BYTES) != hipSuccess || per_cu < 1) { fprintf(stderr, "kernel_launch: occupancy query says %d blocks per CU\n", per_cu); per_cu = 1; }
        (void)hipGetLastError();
        grid = cus * per_cu;
    }
    if (grid < 0) return;
    Args a{};
    a.x = (const float*)d_in[0]; a.meta = (const float*)d_in[1]; a.attn_g = (const float*)d_in[2]; a.w_in = (const float*)d_in[3]; a.fox_b = (const float*)d_in[4];
    a.ret_g = (const float*)d_in[5]; a.w_out = (const float*)d_in[6]; a.ffn_g = (const float*)d_in[7]; a.w_up = (const float*)d_in[8]; a.conv_w = (const float*)d_in[9];
    a.conv_b = (const float*)d_in[10]; a.w_down = (const float*)d_in[11]; a.final_g = (const float*)d_in[12];
    a.out = (float*)d_out; a.ws = (unsigned char*)d_ws;
    void* kargs[] = {&a};
    const hipError_t e = hipLaunchCooperativeKernel((const void*)hymba_fwd, dim3(grid), dim3(NTHR), kargs, LDS_BYTES, stream);
    if (e != hipSuccess) fprintf(stderr, "kernel_launch: cooperative launch failed: %s (grid %d)\n", hipGetErrorString(e), grid);
}
```

```cpp
#include <hip/hip_runtime.h>
#include <hip/hip_cooperative_groups.h>
#include <cstdio>
#include <cstdint>
namespace cg = cooperative_groups;

namespace pg8 {
#define PG8_LAS __attribute__((address_space(3)))
typedef unsigned short bf16_t;
typedef short bf16x8 __attribute__((ext_vector_type(8)));
typedef float f32x4 __attribute__((ext_vector_type(4)));
typedef unsigned u32x4 __attribute__((ext_vector_type(4)));
constexpr int BM = 256, BK = 64, HALF = 128, HTB = HALF * BK * 2  , STAGE_BYTES = 8 * HTB, NXCD = 8, WGM = 8;

__host__ __device__ __forceinline__ int lds_byte(int r, int c) { const int st = (r >> 4) * 2 + (c >> 5), rr = r & 15, cc = c & 31, ob = rr * 64 + cc * 2; return st * 1024 + (ob ^ (((ob >> 9) & 1) << 5)); }
__host__ __device__ __forceinline__ void stage_rc(int b, int& R, int& C) { const int st = b / 1024, sb = b % 1024, swz = sb ^ (((sb >> 9) & 1) << 5); R = (st >> 1) * 16 + swz / 64; C = (st & 1) * 32 + (swz % 64) / 2; }
__host__ __device__ __forceinline__ int perm32(int rho) { const int n = rho >> 4, i = rho & 15; return 8 * (i >> 2) + 4 * n + (i & 3); }

struct Unit { int pm, pn; };
struct Gemm { const bf16_t* A; const bf16_t* Bt; int M, N, K; };

struct StaticOrder {
    int nM, nN, nwg, G, c;
    __host__ __device__ void init(int M, int N, int G_, int c_) { nM = M / BM; nN = N / BM; nwg = nM * nN; G = G_; c = c_; }
    __host__ __device__ bool next(int i, Unit& u) const {
        const long L = (long)i * G + c; if (L >= nwg) return false;
        int wgid = (int)L; { const int q = nwg / NXCD, r = nwg % NXCD, xcd = wgid % NXCD, off = wgid / NXCD; wgid = (xcd < r ? xcd * (q + 1) : r * (q + 1) + (xcd - r) * q) + off; }
        const int nig = WGM * nN, gid = wgid / nig, fm = gid * WGM, gsz = (nM - fm) < WGM ? (nM - fm) : WGM;
        u.pm = fm + ((wgid % nig) % gsz); u.pn = (wgid % nig) / gsz; return true;
    }
    __device__ __forceinline__ void a_ready(const Unit&) const {}
    __device__ __forceinline__ void done(const Unit&) const {}
};

__device__ __forceinline__ unsigned cvt_pk_bf16(float lo, float hi) { unsigned r; asm volatile("v_cvt_pk_bf16_f32 %0, %1, %2" : "=v"(r) : "v"(lo), "v"(hi)); return r; }
typedef float f32x2 __attribute__((ext_vector_type(2)));
__device__ __forceinline__ f32x2 gelu_pk(f32x2 v) {
    const f32x2 av = __builtin_elementwise_abs(v), d = av * 0.2316418882f + 1.0f;
    f32x2 t; t.x = __builtin_amdgcn_rcpf(d.x); t.y = __builtin_amdgcn_rcpf(d.y);
    f32x2 q = t * 0.5307027145f + (-0.7265760135f); q = q * t + 0.7107068705f; q = q * t + (-0.142248368f); q = q * t + 0.127414796f; q = q * t;
    const f32x2 s = (v * v) * (-0.72134752044f);
    f32x2 e; e.x = __builtin_amdgcn_exp2f(s.x); e.y = __builtin_amdgcn_exp2f(s.y);
    const f32x2 m = v * (q * e), r = v - m;
    f32x2 o; o.x = v.x < 0.f ? m.x : r.x; o.y = v.y < 0.f ? m.y : r.y; return o;
}

template <int ACT  > struct EpiBf16 {
    static constexpr bool PERM = true, AFTER_DRAIN = false; static_assert(ACT == 0 || ACT == 1, "EpiBf16: ACT is 0 (none) or 1 (gelu_pk)");
    bf16_t* O; int ldc; const float* bias; int split_cols; size_t split_stride; float scale0;
    __device__ __forceinline__ void operator()(const f32x4 (&acc)[2][2][4][2], const Unit& u, int wr, int wc, int fr, int fq) const {
        const int row0 = u.pm * BM + wr * 64 + fr; int colt = u.pn * BM; bf16_t* base = O;
        float sc = 1.f; if (split_cols) { const int t = colt / split_cols; base += (size_t)t * split_stride; colt -= t * split_cols; if (t == 0) sc = scale0; }
        const int col0 = colt + wc * 32 + 8 * fq, bcol0 = u.pn * BM + wc * 32 + 8 * fq;
        f32x4 bv[2][2];
#pragma unroll
        for (int bj = 0; bj < 2; ++bj)
#pragma unroll
            for (int n = 0; n < 2; ++n) bv[bj][n] = bias ? *(const f32x4*)(bias + bcol0 + bj * HALF + 4 * n) : (f32x4){0.f, 0.f, 0.f, 0.f};
#pragma unroll
        for (int ai = 0; ai < 2; ++ai)
#pragma unroll
            for (int m = 0; m < 4; ++m) { bf16_t* rowp = base + (size_t)(row0 + ai * HALF + m * 16) * ldc + col0;
#pragma unroll
                for (int bj = 0; bj < 2; ++bj) { f32x4 v0 = acc[ai][bj][m][0] + bv[bj][0], v1 = acc[ai][bj][m][1] + bv[bj][1];
                    if (ACT == 1) { f32x2 a = gelu_pk((f32x2){v0[0], v0[1]}), b = gelu_pk((f32x2){v0[2], v0[3]}), c = gelu_pk((f32x2){v1[0], v1[1]}), d = gelu_pk((f32x2){v1[2], v1[3]});
                        v0 = (f32x4){a.x, a.y, b.x, b.y}; v1 = (f32x4){c.x, c.y, d.x, d.y}; }
                    v0 = v0 * sc; v1 = v1 * sc; u32x4 w; w.x = cvt_pk_bf16(v0[0], v0[1]); w.y = cvt_pk_bf16(v0[2], v0[3]); w.z = cvt_pk_bf16(v1[0], v1[1]); w.w = cvt_pk_bf16(v1[2], v1[3]);
                    *(u32x4*)(rowp + bj * HALF) = w; } }
    }
};

__device__ __forceinline__ void unpack_bf16x8(const u32x4 w, float (&o)[8]) {
#pragma unroll
    for (int i = 0; i < 4; ++i) { o[2 * i] = __uint_as_float(w[i] << 16); o[2 * i + 1] = __uint_as_float(w[i] & 0xffff0000u); }
}
struct EpiProj {
    static constexpr bool PERM = true, AFTER_DRAIN = false;
    bf16_t* O; int ldc; unsigned* norms;
    __device__ __forceinline__ void operator()(const f32x4 (&acc)[2][2][4][2], const Unit& u, int wr, int wc, int fr, int fq) const {
        const int row0 = u.pm * BM + wr * 64 + fr + 128 * (u.pm / 16 + 1);
        const int col0 = u.pn * BM + wc * 32 + 8 * fq;
        if (u.pn >= 6 && u.pn < 10) {
            const int which = (u.pn >= 8) ? 1 : 0, b = u.pm / 16;
#pragma unroll
            for (int bj = 0; bj < 2; ++bj) { float mx = 0.f;
#pragma unroll
                for (int ai = 0; ai < 2; ++ai)
#pragma unroll
                    for (int m = 0; m < 4; ++m) { const f32x4 v0 = acc[ai][bj][m][0], v1 = acc[ai][bj][m][1];
                        float ss = (v0[0] * v0[0] + v0[1] * v0[1]) + (v0[2] * v0[2] + v0[3] * v0[3]) + (v1[0] * v1[0] + v1[1] * v1[1]) + (v1[2] * v1[2] + v1[3] * v1[3]);
                        ss += __shfl_xor(ss, 16); ss += __shfl_xor(ss, 32); mx = fmaxf(mx, ss); }
                mx = fmaxf(mx, __shfl_xor(mx, 1)); mx = fmaxf(mx, __shfl_xor(mx, 2)); mx = fmaxf(mx, __shfl_xor(mx, 4)); mx = fmaxf(mx, __shfl_xor(mx, 8));
                const int head = 4 * (u.pn & 1) + 2 * bj + (wc >> 1);
                if (fr == 0 && fq == 0) atomicMax(norms + ((b * 8 + head) * 3 + which) * 2 + (wc & 1), __float_as_uint(mx)); }
        }
#pragma unroll
        for (int ai = 0; ai < 2; ++ai)
#pragma unroll
            for (int m = 0; m < 4; ++m) { bf16_t* rowp = O + (size_t)(row0 + ai * HALF + m * 16) * ldc + col0;
#pragma unroll
                for (int bj = 0; bj < 2; ++bj) { const f32x4 v0 = acc[ai][bj][m][0], v1 = acc[ai][bj][m][1];
                    u32x4 w; w.x = cvt_pk_bf16(v0[0], v0[1]); w.y = cvt_pk_bf16(v0[2], v0[3]); w.z = cvt_pk_bf16(v1[0], v1[1]); w.w = cvt_pk_bf16(v1[2], v1[3]);
                    *(u32x4*)(rowp + bj * HALF) = w; } }
    }
};
struct EpiRes1 {
    static constexpr bool PERM = true, AFTER_DRAIN = false;
    const float* X; bf16_t* H1; float* rowss; int ldc;
    __device__ __forceinline__ void operator()(const f32x4 (&acc)[2][2][4][2], const Unit& u, int wr, int wc, int fr, int fq) const {
        const int row0 = u.pm * BM + wr * 64 + fr, col0 = u.pn * BM + wc * 32 + 8 * fq;
#pragma unroll
        for (int ai = 0; ai < 2; ++ai)
#pragma unroll
            for (int m = 0; m < 4; ++m) { const int row = row0 + ai * HALF + m * 16; const size_t off = (size_t)row * ldc + col0; float ss = 0.f;
#pragma unroll
                for (int bj = 0; bj < 2; ++bj) { const f32x4 x0 = __builtin_nontemporal_load((const f32x4*)(X + off + bj * HALF)), x1 = __builtin_nontemporal_load((const f32x4*)(X + off + bj * HALF + 4));
                    const f32x4 v0 = acc[ai][bj][m][0] + x0, v1 = acc[ai][bj][m][1] + x1;
                    ss += (v0[0] * v0[0] + v0[1] * v0[1]) + (v0[2] * v0[2] + v0[3] * v0[3]) + (v1[0] * v1[0] + v1[1] * v1[1]) + (v1[2] * v1[2] + v1[3] * v1[3]);
                    u32x4 w; w.x = cvt_pk_bf16(v0[0], v0[1]); w.y = cvt_pk_bf16(v0[2], v0[3]); w.z = cvt_pk_bf16(v1[0], v1[1]); w.w = cvt_pk_bf16(v1[2], v1[3]);
                    *(u32x4*)(H1 + off + bj * HALF) = w; }
                ss += __shfl_xor(ss, 16); ss += __shfl_xor(ss, 32);
                if (fq == 0 && rowss) atomicAdd(rowss + row, ss); }
    }
};
struct EpiRes2 {
    static constexpr bool PERM = true, AFTER_DRAIN = false;
    const bf16_t* H1; float* OUT; float* rowss; int ldc;
    __device__ __forceinline__ void operator()(const f32x4 (&acc)[2][2][4][2], const Unit& u, int wr, int wc, int fr, int fq) const {
        const int row0 = u.pm * BM + wr * 64 + fr, col0 = u.pn * BM + wc * 32 + 8 * fq;
#pragma unroll
        for (int ai = 0; ai < 2; ++ai)
#pragma unroll
            for (int m = 0; m < 4; ++m) { const int row = row0 + ai * HALF + m * 16; const size_t off = (size_t)row * ldc + col0; float ss = 0.f;
#pragma unroll
                for (int bj = 0; bj < 2; ++bj) { float hv[8]; unpack_bf16x8(*(const u32x4*)(H1 + off + bj * HALF), hv);
                    const f32x4 v0 = acc[ai][bj][m][0] + (f32x4){hv[0], hv[1], hv[2], hv[3]}, v1 = acc[ai][bj][m][1] + (f32x4){hv[4], hv[5], hv[6], hv[7]};
                    ss += (v0[0] * v0[0] + v0[1] * v0[1]) + (v0[2] * v0[2] + v0[3] * v0[3]) + (v1[0] * v1[0] + v1[1] * v1[1]) + (v1[2] * v1[2] + v1[3] * v1[3]);
                    *(f32x4*)(OUT + off + bj * HALF) = v0; *(f32x4*)(OUT + off + bj * HALF + 4) = v1; }
                ss += __shfl_xor(ss, 16); ss += __shfl_xor(ss, 32);
                if (fq == 0) atomicAdd(rowss + row, ss); }
    }
};
struct EpiRes2N {
    static constexpr bool PERM = true, AFTER_DRAIN = false;
    const bf16_t* H1; float* OUT; float* rowss; unsigned* cnt; const float* fg; int ldc;
    __device__ __forceinline__ void operator()(f32x4 (&acc)[2][2][4][2], const Unit& u, int wr, int wc, int fr, int fq) const {
        const int row0 = u.pm * BM + wr * 64 + fr, col0 = u.pn * BM + wc * 32 + 8 * fq;
#pragma unroll
        for (int ai = 0; ai < 2; ++ai)
#pragma unroll
            for (int m = 0; m < 4; ++m) { const int row = row0 + ai * HALF + m * 16; const size_t off = (size_t)row * ldc + col0; float ss = 0.f;
#pragma unroll
                for (int bj = 0; bj < 2; ++bj) { float hv[8]; unpack_bf16x8(*(const u32x4*)(H1 + off + bj * HALF), hv);
                    const f32x4 v0 = acc[ai][bj][m][0] + (f32x4){hv[0], hv[1], hv[2], hv[3]}, v1 = acc[ai][bj][m][1] + (f32x4){hv[4], hv[5], hv[6], hv[7]};
                    ss += (v0[0] * v0[0] + v0[1] * v0[1]) + (v0[2] * v0[2] + v0[3] * v0[3]) + (v1[0] * v1[0] + v1[1] * v1[1]) + (v1[2] * v1[2] + v1[3] * v1[3]);
                    acc[ai][bj][m][0] = v0; acc[ai][bj][m][1] = v1; }
                ss += __shfl_xor(ss, 16); ss += __shfl_xor(ss, 32);
                if (fq == 0) atomicAdd(rowss + row, ss); }
        asm volatile("s_waitcnt vmcnt(0)" ::: "memory");
        unsigned* c = cnt + 64 * u.pm;
        if (fr == 0 && fq == 0) __hip_atomic_fetch_add(c, 1u, __ATOMIC_RELAXED, __HIP_MEMORY_SCOPE_AGENT);
        { unsigned spins = 0u;
          while ((unsigned)__builtin_amdgcn_readfirstlane((int)__hip_atomic_load(c, __ATOMIC_RELAXED, __HIP_MEMORY_SCOPE_AGENT)) < 32u && ++spins < (1u << 18)) __builtin_amdgcn_s_sleep(2); }
        __builtin_amdgcn_fence(__ATOMIC_ACQUIRE, "agent");
        f32x4 gv[2][2];
#pragma unroll
        for (int bj = 0; bj < 2; ++bj) { gv[bj][0] = *(const f32x4*)(fg + col0 + bj * HALF); gv[bj][1] = *(const f32x4*)(fg + col0 + bj * HALF + 4); }
#pragma unroll
        for (int ai = 0; ai < 2; ++ai)
#pragma unroll
            for (int m = 0; m < 4; ++m) { const int row = row0 + ai * HALF + m * 16; const size_t off = (size_t)row * ldc + col0;
                const float tot = __hip_atomic_load(rowss + row, __ATOMIC_RELAXED, __HIP_MEMORY_SCOPE_AGENT);
                const float rs = __builtin_amdgcn_rsqf(tot * (1.0f / 1024.0f) + 1e-6f);
#pragma unroll
                for (int bj = 0; bj < 2; ++bj) { *(f32x4*)(OUT + off + bj * HALF) = acc[ai][bj][m][0] * rs * gv[bj][0]; *(f32x4*)(OUT + off + bj * HALF + 4) = acc[ai][bj][m][1] * rs * gv[bj][1]; } }
    }
};
__device__ __forceinline__ float dpp_shr1(float old, float src) { return __int_as_float(__builtin_amdgcn_update_dpp(__float_as_int(old), __float_as_int(src), 0x111, 0xf, 0xf, false)); }
__device__ __forceinline__ float dpp_shr2(float old, float src) { return __int_as_float(__builtin_amdgcn_update_dpp(__float_as_int(old), __float_as_int(src), 0x112, 0xf, 0xf, false)); }
__device__ __forceinline__ float dpp_ror1(float src) { return __int_as_float(__builtin_amdgcn_update_dpp(0, __float_as_int(src), 0x121, 0xf, 0xf, false)); }
__device__ __forceinline__ float dpp_ror2(float src) { return __int_as_float(__builtin_amdgcn_update_dpp(0, __float_as_int(src), 0x122, 0xf, 0xf, false)); }
struct EpiUp {
    static constexpr bool PERM = true, AFTER_DRAIN = false;
    bf16_t* G; const float* rowss; const float* cw; const float* cb; float* atail; float* ahead; float* bhead;
    __device__ __forceinline__ void operator()(const f32x4 (&acc)[2][2][4][2], const Unit& u, int wr, int wc, int fr, int fq) const {
        constexpr int FF = 2816;
        const int f0 = u.pn * 128 + wc * 32 + 8 * fq;
        f32x2 w0[4], w1[4], w2[4], c0[4];
#pragma unroll
        for (int q = 0; q < 2; ++q) { const f32x4 a = *(const f32x4*)(cw + f0 + 4 * q), b = *(const f32x4*)(cw + FF + f0 + 4 * q), c = *(const f32x4*)(cw + 2 * FF + f0 + 4 * q), d = *(const f32x4*)(cb + f0 + 4 * q);
            w0[2 * q] = (f32x2){a[0], a[1]}; w0[2 * q + 1] = (f32x2){a[2], a[3]}; w1[2 * q] = (f32x2){b[0], b[1]}; w1[2 * q + 1] = (f32x2){b[2], b[3]};
            w2[2 * q] = (f32x2){c[0], c[1]}; w2[2 * q + 1] = (f32x2){c[2], c[3]}; c0[2 * q] = (f32x2){d[0], d[1]}; c0[2 * q + 1] = (f32x2){d[2], d[3]}; }
#pragma unroll
        for (int ai = 0; ai < 2; ++ai) {
            const int sidx = 4 * u.pm + 2 * ai + wr;
            f32x2 pa[4];
#pragma unroll
            for (int c = 0; c < 4; ++c) pa[c] = (f32x2){0.f, 0.f};
#pragma unroll
            for (int m = 0; m < 4; ++m) {
                const int row = u.pm * BM + ai * HALF + wr * 64 + m * 16 + fr;
                const float rs = __builtin_amdgcn_rsqf(rowss[row] * (1.0f / 1024.0f) + 1e-6f);
                f32x2 a[4], b[4], g[4];
#pragma unroll
                for (int n = 0; n < 2; ++n) { const f32x4 av = acc[ai][0][m][n], bv = acc[ai][1][m][n];
                    a[2 * n] = (f32x2){av[0], av[1]} * rs; a[2 * n + 1] = (f32x2){av[2], av[3]} * rs; b[2 * n] = (f32x2){bv[0], bv[1]} * rs; b[2 * n + 1] = (f32x2){bv[2], bv[3]} * rs; }
#pragma unroll
                for (int c = 0; c < 4; ++c) {
                    f32x2 p1, p2;
                    { const float o1 = (m > 0) ? dpp_ror1(pa[c].x) : 0.f, o2 = (m > 0) ? dpp_ror2(pa[c].x) : 0.f; p1.x = dpp_shr1(o1, a[c].x); p2.x = dpp_shr2(o2, a[c].x); }
                    { const float o1 = (m > 0) ? dpp_ror1(pa[c].y) : 0.f, o2 = (m > 0) ? dpp_ror2(pa[c].y) : 0.f; p1.y = dpp_shr1(o1, a[c].y); p2.y = dpp_shr2(o2, a[c].y); }
                    const f32x2 z = c0[c] + w0[c] * p2 + w1[c] * p1 + w2[c] * a[c];
                    const f32x2 t = z * (-1.4426950408889634f);
                    f32x2 sg; sg.x = __builtin_amdgcn_rcpf(1.0f + __builtin_amdgcn_exp2f(t.x)); sg.y = __builtin_amdgcn_rcpf(1.0f + __builtin_amdgcn_exp2f(t.y));
                    g[c] = (z * b[c]) * sg;
                }
                u32x4 w; w.x = cvt_pk_bf16(g[0].x, g[0].y); w.y = cvt_pk_bf16(g[1].x, g[1].y); w.z = cvt_pk_bf16(g[2].x, g[2].y); w.w = cvt_pk_bf16(g[3].x, g[3].y);
                *(u32x4*)(G + (size_t)row * FF + f0) = w;
                if (m == 3 && fr >= 14) { float* p = atail + (size_t)(sidx * 2 + (fr - 14)) * FF + f0; *(f32x4*)p = (f32x4){a[0].x, a[0].y, a[1].x, a[1].y}; *(f32x4*)(p + 4) = (f32x4){a[2].x, a[2].y, a[3].x, a[3].y}; }
                if (m == 0 && fr < 2) { float* p = ahead + (size_t)(sidx * 2 + fr) * FF + f0; *(f32x4*)p = (f32x4){a[0].x, a[0].y, a[1].x, a[1].y}; *(f32x4*)(p + 4) = (f32x4){a[2].x, a[2].y, a[3].x, a[3].y};
                    float* q = bhead + (size_t)(sidx * 2 + fr) * FF + f0; *(f32x4*)q = (f32x4){b[0].x, b[0].y, b[1].x, b[1].y}; *(f32x4*)(q + 4) = (f32x4){b[2].x, b[2].y, b[3].x, b[3].y}; }
#pragma unroll
                for (int c = 0; c < 4; ++c) pa[c] = a[c];
            }
        }
    }
};

template <class Epi, class Sched, bool ALIGN_EPI = false, bool SP2 = false>
__device__ __forceinline__ void gemm_phase(PG8_LAS unsigned char* lds, const Gemm g, const Sched& S, const Epi& E) {
    int tid_ = threadIdx.x; asm volatile("" : "+v"(tid_));
    const int tid = tid_, wid = __builtin_amdgcn_readfirstlane(tid >> 6), lane = tid & 63, wr = wid >> 2, wc = wid & 3, fr = lane & 15, fq = lane >> 4;
    const int K = g.K, nt = K / BK;
    unsigned voffA[2], voffB[2];
#pragma unroll
    for (int i = 0; i < 2; ++i) { int R, C; stage_rc(tid * 16 + i * 8192, R, C); const int Rb = Epi::PERM ? ((R & ~31) + perm32(R & 31)) : R;
        voffA[i] = (unsigned)(R * K + C) * 2u; voffB[i] = (unsigned)(Rb * K + C) * 2u; }
    const size_t kstep = (size_t)(BK * 2);
    const size_t hstep = (size_t)HALF * K * 2;
    const size_t tstep = 2 * hstep;
    const unsigned ldsw = (unsigned)wid * 1024u;
    const int aoff = lds_byte(wr * 64 + fr, fq * 8), boff = lds_byte(wc * 32 + fr, fq * 8);
#define PG8_SA(b, h) (((b) * 2 + (h)) * HTB)
#define PG8_SB(b, h) ((4 + (b) * 2 + (h)) * HTB)
#define PG8_STAGE(bufoff, gbase, voff) do { _Pragma("unroll") for (int _i = 0; _i < 2; ++_i) \
        __builtin_amdgcn_global_load_lds((const unsigned*)((const char*)(gbase) + (voff)[_i]), (PG8_LAS unsigned*)(lds + (bufoff) + ldsw + _i * 8192), 16, 0, 0); } while (0)
#define PG8_LDA(dst, b, h) do { _Pragma("unroll") for (int m = 0; m < 4; ++m) _Pragma("unroll") for (int k = 0; k < 2; ++k) dst[m][k] = *(const PG8_LAS bf16x8*)(lds + PG8_SA(b, h) + aoff + m * 2048 + k * 1024); } while (0)
#define PG8_LDB(dst, b, h) do { _Pragma("unroll") for (int n = 0; n < 2; ++n) _Pragma("unroll") for (int k = 0; k < 2; ++k) dst[n][k] = *(const PG8_LAS bf16x8*)(lds + PG8_SB(b, h) + boff + n * 2048 + k * 1024); } while (0)
#define PG8_MMA(ai, bj, At, Bt) do { __builtin_amdgcn_s_setprio(1); _Pragma("unroll") for (int m = 0; m < 4; ++m) _Pragma("unroll") for (int n = 0; n < 2; ++n) _Pragma("unroll") for (int k = 0; k < 2; ++k) \
        acc[ai][bj][m][n] = __builtin_amdgcn_mfma_f32_16x16x32_bf16(Bt[n][k], At[m][k], acc[ai][bj][m][n], 0, 0, 0); __builtin_amdgcn_s_setprio(0); } while (0)
#define PG8_WAIT_V(n) asm volatile("s_waitcnt vmcnt(" #n ")" ::: "memory")
#define PG8_WAIT_L(n) asm volatile("s_waitcnt lgkmcnt(" #n ")" ::: "memory")
#define PG8_BAR __builtin_amdgcn_s_barrier()
#define PG8_SCHED __builtin_amdgcn_sched_barrier(0)
    Unit cur, nxt; int ui = 0;
    if (!S.next(0, cur)) return;
    f32x4 acc[2][2][4][2];
#pragma unroll
    for (int a = 0; a < 2; ++a)
#pragma unroll
        for (int b = 0; b < 2; ++b)
#pragma unroll
            for (int m = 0; m < 4; ++m)
#pragma unroll
                for (int n = 0; n < 2; ++n) acc[a][b][m][n] = (f32x4){0.f, 0.f, 0.f, 0.f};
    bf16x8 At[4][2], B0[2][2], B1[2][2];
    const char* cA = (const char*)g.A + (size_t)cur.pm * tstep; const char* cB = (const char*)g.Bt + (size_t)cur.pn * tstep;
    S.a_ready(cur);
    if constexpr (SP2) {
        PG8_STAGE(PG8_SB(0, 0), cB, voffB); PG8_STAGE(PG8_SB(0, 1), cB + hstep, voffB); PG8_STAGE(PG8_SA(0, 0), cA, voffA); PG8_STAGE(PG8_SA(0, 1), cA + hstep, voffA);
        if (wr == 1) PG8_BAR;
        PG8_WAIT_V(2); PG8_BAR;
        PG8_STAGE(PG8_SB(1, 0), cB + kstep, voffB); PG8_STAGE(PG8_SA(1, 0), cA + kstep, voffA); PG8_STAGE(PG8_SB(1, 1), cB + hstep + kstep, voffB);
        PG8_WAIT_V(6); PG8_BAR;
    } else {
        PG8_STAGE(PG8_SB(0, 0), cB, voffB); PG8_STAGE(PG8_SA(0, 0), cA, voffA); PG8_STAGE(PG8_SB(0, 1), cB + hstep, voffB); PG8_STAGE(PG8_SA(0, 1), cA + hstep, voffA);
        if (wr == 1) PG8_BAR;
        PG8_WAIT_V(4); PG8_BAR;
        PG8_STAGE(PG8_SB(1, 0), cB + kstep, voffB); PG8_STAGE(PG8_SA(1, 0), cA + kstep, voffA); PG8_STAGE(PG8_SB(1, 1), cB + hstep + kstep, voffB);
        PG8_WAIT_V(6); PG8_BAR;
    }
    for (;;) {
        const bool has_next = S.next(ui + 1, nxt);
        const char* nA = has_next ? (const char*)g.A + (size_t)nxt.pm * tstep : cA; const char* nB = has_next ? (const char*)g.Bt + (size_t)nxt.pn * tstep : cB;
        for (int t = 0; t < nt; t += 2) {
            const bool last = (t == nt - 2);
            const char* a1 = cA + (size_t)(t + 1) * kstep;
            const char* a2 = last ? nA : cA + (size_t)(t + 2) * kstep; const char* b2 = last ? nB : cB + (size_t)(t + 2) * kstep;
            const char* a3 = a2 + kstep; const char* b3 = b2 + kstep;
            if (last && has_next) S.a_ready(nxt);
            if constexpr (SP2) {
            PG8_LDB(B0, 0, 0); PG8_LDB(B1, 0, 1); PG8_SCHED; PG8_LDA(At, 0, 0); PG8_STAGE(PG8_SA(1, 1), a1 + hstep, voffA);
            PG8_WAIT_V(8); PG8_WAIT_L(0); PG8_BAR; PG8_MMA(0, 0, At, B0); PG8_MMA(0, 1, At, B1); PG8_BAR; PG8_SCHED;
            PG8_LDA(At, 0, 1); PG8_STAGE(PG8_SB(0, 0), b2, voffB); PG8_STAGE(PG8_SB(0, 1), b2 + hstep, voffB); PG8_STAGE(PG8_SA(0, 0), a2, voffA);
            PG8_WAIT_V(8); PG8_WAIT_L(0); PG8_BAR; PG8_MMA(1, 0, At, B0); PG8_MMA(1, 1, At, B1); PG8_BAR; PG8_SCHED;
            PG8_LDB(B0, 1, 0); PG8_LDB(B1, 1, 1); PG8_SCHED; PG8_LDA(At, 1, 0); PG8_STAGE(PG8_SA(0, 1), a2 + hstep, voffA);
            PG8_WAIT_V(8); PG8_WAIT_L(0); PG8_BAR; PG8_MMA(0, 0, At, B0); PG8_MMA(0, 1, At, B1); PG8_BAR; PG8_SCHED;
            PG8_LDA(At, 1, 1); PG8_STAGE(PG8_SB(1, 0), b3, voffB); PG8_STAGE(PG8_SB(1, 1), b3 + hstep, voffB); PG8_STAGE(PG8_SA(1, 0), a3, voffA);
            PG8_WAIT_V(8); PG8_WAIT_L(0); PG8_BAR; PG8_MMA(1, 0, At, B0); PG8_MMA(1, 1, At, B1); PG8_BAR; PG8_SCHED;
            } else {
            PG8_LDB(B0, 0, 0); PG8_SCHED; PG8_LDA(At, 0, 0); PG8_STAGE(PG8_SA(1, 1), a1 + hstep, voffA);
            PG8_WAIT_L(8); PG8_BAR; PG8_WAIT_L(0); PG8_MMA(0, 0, At, B0); PG8_BAR; PG8_SCHED;
            PG8_LDB(B1, 0, 1); PG8_STAGE(PG8_SB(0, 0), b2, voffB);
            PG8_BAR; PG8_WAIT_L(0); PG8_MMA(0, 1, At, B1); PG8_BAR;
            PG8_LDA(At, 0, 1); PG8_STAGE(PG8_SA(0, 0), a2, voffA);
            PG8_BAR; PG8_WAIT_L(0); PG8_MMA(1, 0, At, B0); PG8_BAR; PG8_SCHED;
            PG8_STAGE(PG8_SB(0, 1), b2 + hstep, voffB);
            PG8_WAIT_V(6); PG8_BAR; PG8_MMA(1, 1, At, B1); PG8_BAR;
            PG8_LDB(B0, 1, 0); PG8_SCHED; PG8_LDA(At, 1, 0); PG8_STAGE(PG8_SA(0, 1), a2 + hstep, voffA);
            PG8_WAIT_L(8); PG8_BAR; PG8_WAIT_L(0); PG8_MMA(0, 0, At, B0); PG8_BAR; PG8_SCHED;
            PG8_LDB(B1, 1, 1); PG8_STAGE(PG8_SB(1, 0), b3, voffB);
            PG8_BAR; PG8_WAIT_L(0); PG8_MMA(0, 1, At, B1); PG8_BAR;
            PG8_LDA(At, 1, 1); PG8_STAGE(PG8_SA(1, 0), a3, voffA);
            PG8_BAR; PG8_WAIT_L(0); PG8_MMA(1, 0, At, B0); PG8_BAR; PG8_SCHED;
            PG8_STAGE(PG8_SB(1, 1), b3 + hstep, voffB);
            PG8_WAIT_V(6); PG8_BAR; PG8_MMA(1, 1, At, B1); PG8_BAR;
            }
        }
        if constexpr (ALIGN_EPI) { if (wr == 0) PG8_BAR; }
        if constexpr (!Epi::AFTER_DRAIN) { E(acc, cur, wr, wc, fr, fq); S.done(cur); }
        if (!has_next) break;
#pragma unroll
        for (int a = 0; a < 2; ++a)
#pragma unroll
            for (int b = 0; b < 2; ++b)
#pragma unroll
                for (int m = 0; m < 4; ++m)
#pragma unroll
                    for (int n = 0; n < 2; ++n) acc[a][b][m][n] = (f32x4){0.f, 0.f, 0.f, 0.f};
        cur = nxt; cA = nA; cB = nB; ++ui;
        if constexpr (ALIGN_EPI) { if (wr == 1) PG8_BAR; }
    }
    PG8_WAIT_V(0);
    if constexpr (!ALIGN_EPI) { if (wr == 0) PG8_BAR; }
    PG8_BAR;
    if constexpr (Epi::AFTER_DRAIN) { E.fused(acc, cur, wr, wc, fr, fq, lds, wid, lane); S.done(cur); }
#undef PG8_SA
#undef PG8_SB
#undef PG8_STAGE
#undef PG8_LDA
#undef PG8_LDB
#undef PG8_MMA
#undef PG8_WAIT_V
#undef PG8_WAIT_L
#undef PG8_BAR
#undef PG8_SCHED
}
}

#include <hip/hip_bf16.h>
#include <cmath>
namespace attn_body {
using bf16=__hip_bfloat16;
using bf16x8=__attribute__((ext_vector_type(8)))short;
using s16x4=__attribute__((ext_vector_type(4)))short;
using f32x16=__attribute__((ext_vector_type(16)))float;
using u32x4=__attribute__((ext_vector_type(4)))unsigned;
typedef float f32x4_t __attribute__((ext_vector_type(4)));
constexpr int BATCH=8,NHEAD=8,SEQ=4224,D=64,DM=3072,OPITCH=1024,OCOL0=512,FRAMES=4096,QOFF=128;
constexpr int NW=8,QBLK=32,QB=QBLK*NW,KVBLK=64,NQB=FRAMES/QB;
constexpr int ATTN_PITCH=DM, ATTN_UNIT_ROWS=QB;
__device__ __forceinline__ int crow(int r,int hi){return (r&3)+8*(r>>2)+4*hi;}
#define SBAR() __builtin_amdgcn_sched_barrier(0)
__device__ __forceinline__ void cmask(f32x16&p0,f32x16&p1,int jb,int qrel,int hi){
  const float NEG=-INFINITY; int kb=64*jb+4*hi;
  #pragma unroll
  for(int r=0;r<16;++r){int kv=kb+(r&3)+8*(r>>2); if(kv>qrel)p0[r]=NEG; if(kv+32>qrel)p1[r]=NEG;}
}

constexpr int NSLOT=3, SLOTB=8192;
constexpr int LDS_K=0, LDS_V=NSLOT*SLOTB, LDS_WS=2*NSLOT*SLOTB, LDS_OST=LDS_WS+NW*64*4, LDS_BIAS=LDS_OST+NW*4096, LDS_BYTES=LDS_BIAS+SEQ*4;
constexpr float C2=0.125f*1.4426950408889634f;
__device__ __forceinline__ void glds16(const void*gsrc,unsigned lds_dst){unsigned keep;
  asm volatile("s_mov_b32 %0, m0\n\ts_mov_b32 m0, %2\n\ts_nop 0\n\tglobal_load_lds_dwordx4 %1, off\n\ts_mov_b32 m0, %0":"=&s"(keep):"v"(gsrc),"s"(lds_dst):"memory");}
__device__ __forceinline__ float max3f(float a,float b,float c){float r;asm("v_max3_f32 %0, %1, %2, %3":"=v"(r):"v"(a),"v"(b),"v"(c));return r;}
__device__ __forceinline__ float max2f(float a,float b){float r;asm("v_max_f32_e32 %0, %1, %2":"=v"(r):"v"(a),"v"(b));return r;}
__device__ __forceinline__ float fadd_s(float a,float b){float r;asm("v_add_f32_e32 %0, %1, %2":"=v"(r):"v"(a),"v"(b));return r;}
__device__ __forceinline__ float fsub_s(float a,float b){float r;asm("v_sub_f32_e32 %0, %1, %2":"=v"(r):"v"(a),"v"(b));return r;}
typedef float f32x2_t __attribute__((ext_vector_type(2))); typedef __bf16 bf16x2_t __attribute__((ext_vector_type(2)));
__device__ __forceinline__ unsigned cvtpk_s(float lo,float hi){f32x2_t v={lo,hi};bf16x2_t b=__builtin_convertvector(v,bf16x2_t);return __builtin_bit_cast(unsigned,b);}
#define WAIT_BAR(N) asm volatile("s_waitcnt vmcnt(" #N ") lgkmcnt(0)\n\ts_barrier":::"memory")

__device__ __forceinline__ void qkt(f32x16&p0,f32x16&p1,const char*Kslot,const bf16x8*qr,int r32,int hi){
  const char*kb=Kslot+hi*1024+r32*16;
  #pragma unroll
  for(int d0=0;d0<4;++d0){
    const bf16x8 b0=*reinterpret_cast<const bf16x8*>(kb+d0*2048);
    const bf16x8 b1=*reinterpret_cast<const bf16x8*>(kb+d0*2048+512);
    {p0=__builtin_amdgcn_mfma_f32_32x32x16_bf16(b0,qr[d0],p0,0,0,0);p1=__builtin_amdgcn_mfma_f32_32x32x16_bf16(b1,qr[d0],p1,0,0,0);}}
}
typedef __attribute__((address_space(3))) const char* lds_cptr;
typedef short v4i16_t __attribute__((ext_vector_type(4)));
__device__ __forceinline__ void kload8(bf16x8*kf,lds_cptr kp){
  kf[0]=*(const __attribute__((address_space(3))) bf16x8*)(kp);      kf[1]=*(const __attribute__((address_space(3))) bf16x8*)(kp+512);
  kf[2]=*(const __attribute__((address_space(3))) bf16x8*)(kp+2048); kf[3]=*(const __attribute__((address_space(3))) bf16x8*)(kp+2560);
  kf[4]=*(const __attribute__((address_space(3))) bf16x8*)(kp+4096); kf[5]=*(const __attribute__((address_space(3))) bf16x8*)(kp+4608);
  kf[6]=*(const __attribute__((address_space(3))) bf16x8*)(kp+6144); kf[7]=*(const __attribute__((address_space(3))) bf16x8*)(kp+6656);
}
__device__ __forceinline__ void kload2(bf16x8*kf,lds_cptr kp,int j){ kf[2*j]=*(const __attribute__((address_space(3))) bf16x8*)(kp+j*2048); kf[2*j+1]=*(const __attribute__((address_space(3))) bf16x8*)(kp+j*2048+512); }
__device__ __forceinline__ s16x4 vtr(lds_cptr p){ return __builtin_bit_cast(s16x4,__builtin_amdgcn_ds_read_tr16_b64_v4i16((__attribute__((address_space(3))) v4i16_t*)p)); }
__device__ __forceinline__ float rowmax(const f32x16&p0,const f32x16&p1){
  float a=max3f(p0[0],p0[1],p1[0]),b=max3f(p0[2],p0[3],p1[1]);a=max3f(a,p1[2],p1[3]);
  #pragma unroll
  for(int r=4;r<16;r+=4){a=max3f(a,p0[r],p0[r+1]);b=max3f(b,p0[r+2],p0[r+3]);a=max3f(a,p1[r],p1[r+1]);b=max3f(b,p1[r+2],p1[r+3]);}
  const float m=max2f(a,b);
  auto rr=__builtin_amdgcn_permlane32_swap(__float_as_uint(m),__float_as_uint(m),false,false);
  return max2f(__uint_as_float(rr[0]),__uint_as_float(rr[1]));
}
__device__ __forceinline__ void pv(f32x16*o,int vb,bf16x8 pa0,bf16x8 pa1,bf16x8 pa2,bf16x8 pa3){
  #pragma unroll
  for(int d0=0;d0<2;++d0){s16x4 lo[4],hi[4];
    #pragma unroll
    for(int ks=0;ks<4;++ks){
      asm volatile("ds_read_b64_tr_b16 %0,%1 offset:%c2":"=&v"(lo[ks]):"v"(vb),"i"(d0*4096+ks*1024):"memory");
      asm volatile("ds_read_b64_tr_b16 %0,%1 offset:%c2":"=&v"(hi[ks]):"v"(vb),"i"(d0*4096+ks*1024+512):"memory");}
    asm volatile("s_waitcnt lgkmcnt(0)":::"memory");SBAR();
    #define PK(k) (bf16x8){lo[k][0],lo[k][1],lo[k][2],lo[k][3],hi[k][0],hi[k][1],hi[k][2],hi[k][3]}
    o[d0]=__builtin_amdgcn_mfma_f32_32x32x16_bf16(pa0,PK(0),o[d0],0,0,0);
    o[d0]=__builtin_amdgcn_mfma_f32_32x32x16_bf16(pa1,PK(1),o[d0],0,0,0);
    o[d0]=__builtin_amdgcn_mfma_f32_32x32x16_bf16(pa2,PK(2),o[d0],0,0,0);
    o[d0]=__builtin_amdgcn_mfma_f32_32x32x16_bf16(pa3,PK(3),o[d0],0,0,0);
    #undef PK
  }
}

#ifndef ATTN_STORE16
#define ATTN_STORE16(p,v) (*(u32x4*)(p)=(v))
#endif
template<int THRL> __device__ __forceinline__ void attn_unit(int b,int h,int qb,const bf16*Q,const bf16*__restrict__ K,const bf16*__restrict__ V,bf16*O,const float*__restrict__ BIAS,int t0,unsigned*qctr,unsigned&qnext,char*shm){
  int tid_=threadIdx.x; asm volatile("":"+v"(tid_)); const int tid=tid_,lane=tid&63,r32=lane&31,hi=lane>>5; const int wid=__builtin_amdgcn_readfirstlane(tid>>6);
  const long rowbase=(long)b*SEQ; const int q0=QOFF+qb*QB;
  const bf16*Qw=Q+(rowbase+q0+wid*QBLK)*DM+h*D;
  const bf16*Kh=K+(rowbase+(long)t0*KVBLK)*DM+h*D,*Vh=V+(rowbase+(long)t0*KVBLK)*DM+h*D;
  const unsigned lds0=(unsigned)(uintptr_t)shm;
  float*wsf=(float*)(shm+LDS_WS)+wid*64;
  const bf16*ksrc=Kh+(long)lane*DM+wid*8;
  const bf16*vsrc=Vh+(long)(16*(wid&3)+(lane>>2))*DM+(wid>>2)*32+(lane&3)*8;
  const unsigned kdst=lds0+LDS_K+wid*1024, vdst=lds0+LDS_V+wid*1024;
  #define DMA_K(t,slot) glds16(ksrc+(long)(t)*KVBLK*DM,(unsigned)__builtin_amdgcn_readfirstlane(kdst+(slot)))
  #define DMA_V(t,slot) glds16(vsrc+(long)(t)*KVBLK*DM,(unsigned)__builtin_amdgcn_readfirstlane(vdst+(slot)))
  const int vb0=(int)(lds0+LDS_V)+((lane>>4)&1)*32+(lane&3)*8+(4*hi+((lane&15)>>2))*64;
  const char*Kbase=shm+LDS_K; bf16x8 kf[8];
  const lds_cptr shm3=(lds_cptr)shm; const lds_cptr kp0=shm3+LDS_K+hi*1024+r32*16; const lds_cptr vp0=shm3+LDS_V+((lane>>4)&1)*32+(lane&3)*8+(4*hi+((lane&15)>>2))*64;
  const int NT=(q0+QB)/KVBLK-t0;
  DMA_K(0,0);DMA_V(0,0);DMA_K(1,SLOTB);
  bf16x8 qr[4];
  #pragma unroll
  for(int d0=0;d0<4;++d0)qr[d0]=*reinterpret_cast<const bf16x8*>(&Qw[(long)r32*DM+d0*16+hi*8]);
  float mhat=0.f,l_reg=0.f;f32x16 o[2];o[0]=f32x16{};o[1]=f32x16{};
  typedef __attribute__((address_space(3))) const f32x4_t* lds_f4p; const lds_f4p biasp=(lds_f4p)(shm3+LDS_BIAS)+hi;
  #define BINIT(C0_,C1_,t_) do{ const lds_f4p bp_=biasp+(t_)*16; _Pragma("unroll") for(int g_=0;g_<4;++g_){ const f32x4_t v0_=bp_[2*g_],v1_=bp_[2*g_+8]; \
      _Pragma("unroll") for(int i_=0;i_<4;++i_){ C0_[4*g_+i_]=v0_[i_]; C1_[4*g_+i_]=v1_[i_]; } } }while(0)
  const int qrel=wid*QBLK+r32;
  #define CMASK(P0,P1,t) do{int jb_=(t)-(NT-4); if(jb_>=0)cmask(P0,P1,jb_,qrel,hi);}while(0)
  bool resc=false;
  #define START(P0,P1) do{ const float rm=rowmax(P0,P1); resc=false; mhat=rm; \
    _Pragma("unroll") for(int r=0;r<16;++r)P0[r]=__builtin_amdgcn_exp2f(P0[r]-mhat); }while(0)
  #define RESC() do{ if(resc){ asm volatile("s_waitcnt lgkmcnt(0)":::"memory"); \
      _Pragma("unroll") for(int d_=0;d_<2;++d_) _Pragma("unroll") for(int r=0;r<16;++r)o[d_][r]*=wsf[crow(r,hi)]; } }while(0)
  f32x16 pA0,pA1,pB0,pB1;
  int sl_prev=0,sl_cur=0,sl_next=SLOTB;
  #define ROT() do{sl_prev=sl_cur;sl_cur=sl_next;sl_next=(sl_next==(NSLOT-1)*SLOTB)?0:sl_next+SLOTB;}while(0)
  DMA_K(2,2*SLOTB);
  { const float* bsrc=BIAS+(long)(b*NHEAD+h)*SEQ+t0*KVBLK; __attribute__((address_space(3))) float* bdst=(__attribute__((address_space(3))) float*)(shm3+LDS_BIAS); for(int i_=tid;i_<q0+QB-t0*KVBLK;i_+=NW*64) bdst[i_]=bsrc[i_]; }
  WAIT_BAR(3);
  BINIT(pA0,pA1,0); qkt(pA0,pA1,Kbase,qr,r32,hi);asm volatile("s_nop 15\n\ts_nop 7":"+v"(pA0),"+v"(pA1));CMASK(pA0,pA1,0);
  START(pA0,pA1);
  _Pragma("unroll") for(int r=0;r<16;++r)pA1[r]=__builtin_amdgcn_exp2f(pA1[r]-mhat);
  WAIT_BAR(0);
  DMA_K(3,0);DMA_V(1,SLOTB);
  ROT();
  kload8(kf,kp0+sl_cur);
  WAIT_BAR(2);
  s16x4 vlo[8],vhi[8]; u32x4 pw0,pw1,pw2,pw3;
  #define PKW(P,B) cvtpk_s(P[B],P[B+1])
  #define PAF(k) __builtin_bit_cast(bf16x8,pw##k)
  #define VFR(i) (bf16x8){vlo[i][0],vlo[i][1],vlo[i][2],vlo[i][3],vhi[i][0],vhi[i][1],vhi[i][2],vhi[i][3]}
  #define PIN(x) asm volatile("":"+v"(x))
  #define MX3(a,b,c) __builtin_fmaxf(__builtin_fmaxf((a),(b)),(c))
  #define GAPA(MF,A0,A1,A2,A3,W0,W1,PW) do{ MF; sacc+=A0; sacc+=A1; sacc+=A2; sacc+=A3; PIN(sacc); W0; W1; PIN(PW); SBAR(); }while(0)
  #define EX(v) __builtin_amdgcn_exp2f(v)
  #define GAPB(MF,X,B) do{ MF; X[B]=EX(X[B]-mhat); X[B+1]=EX(X[B+1]-mhat); X[B+2]=EX(X[B+2]-mhat); X[B+3]=EX(X[B+3]-mhat); PIN(X); SBAR(); }while(0)
  #define VRD(i) do{ vlo[i]=vtr(vp_+(((i)>>2)*4096+((i)&3)*1024)); vhi[i]=vtr(vp_+(((i)>>2)*4096+((i)&3)*1024+512)); }while(0)
  #define KRD(G,j) do{ if(G){ kload2(kf,kp0+sl_next,j); SBAR(); } }while(0)
  #define STEP(C0,C1,P0,P1,t,GK,GV,GL) do{ SBAR(); \
    const lds_cptr vp_=vp0+sl_prev; \
    VRD(0); SBAR(); float sacc=(P0[0]+P0[1]); \
    GAPA(C0=__builtin_amdgcn_mfma_f32_32x32x16_bf16(kf[0],qr[0],C0,0,0,0), P0[2],P0[3],P0[4],P0[5],     pw0[0]=PKW(P0,0), pw0[1]=PKW(P0,2), pw0); \
    VRD(4); SBAR(); GAPA(C1=__builtin_amdgcn_mfma_f32_32x32x16_bf16(kf[1],qr[0],C1,0,0,0), P0[6],P0[7],P0[8],P0[9],     pw0[2]=PKW(P0,4), pw0[3]=PKW(P0,6), pw0); \
    VRD(1); SBAR(); GAPA(C0=__builtin_amdgcn_mfma_f32_32x32x16_bf16(kf[2],qr[1],C0,0,0,0),   P0[10],P0[11],P0[12],P0[13], pw1[0]=PKW(P0,8), pw1[1]=PKW(P0,10), pw1); \
    VRD(5); SBAR(); GAPA(C1=__builtin_amdgcn_mfma_f32_32x32x16_bf16(kf[3],qr[1],C1,0,0,0),   P0[14],P0[15],P1[0],P1[1],   pw1[2]=PKW(P0,12),pw1[3]=PKW(P0,14), pw1); \
    VRD(2); SBAR(); GAPA(C0=__builtin_amdgcn_mfma_f32_32x32x16_bf16(kf[4],qr[2],C0,0,0,0),   P1[2],P1[3],P1[4],P1[5],     pw2[0]=PKW(P1,0), pw2[1]=PKW(P1,2), pw2); \
    VRD(6); SBAR(); GAPA(C1=__builtin_amdgcn_mfma_f32_32x32x16_bf16(kf[5],qr[2],C1,0,0,0),   P1[6],P1[7],P1[8],P1[9],     pw2[2]=PKW(P1,4), pw2[3]=PKW(P1,6), pw2); \
    VRD(3); SBAR(); GAPA(C0=__builtin_amdgcn_mfma_f32_32x32x16_bf16(kf[6],qr[3],C0,0,0,0),   P1[10],P1[11],P1[12],P1[13], pw3[0]=PKW(P1,8), pw3[1]=PKW(P1,10), pw3); \
    VRD(7); SBAR(); GAPA(C1=__builtin_amdgcn_mfma_f32_32x32x16_bf16(kf[7],qr[3],C1,0,0,0),   P1[14],P1[15],0.f,0.f,       pw3[2]=PKW(P1,12),pw3[3]=PKW(P1,14), pw3); \
    l_reg+=sacc; \
    if(GK){DMA_K((t)+3,sl_cur);} if(GV){DMA_V((t)+1,sl_next);} \
    BINIT(P0,P1,(t)+1); \
    CMASK(C0,C1,t); \
    { float a=MX3(C0[0],C0[1],C1[0]),b=MX3(C0[2],C0[3],C1[1]); a=MX3(a,C1[2],C1[3]); \
      _Pragma("unroll") for(int r=4;r<16;r+=4){a=MX3(a,C0[r],C0[r+1]);b=MX3(b,C0[r+2],C0[r+3]);a=MX3(a,C1[r],C1[r+1]);b=MX3(b,C1[r+2],C1[r+3]);} \
      float rm=__builtin_fmaxf(a,b); { auto rr=__builtin_amdgcn_permlane32_swap(__float_as_uint(rm),__float_as_uint(rm),false,false); rm=__builtin_fmaxf(__uint_as_float(rr[0]),__uint_as_float(rr[1])); } \
      resc=false; \
      const float rmr=rm-mhat; \
      if(__any(rmr>(float)THRL)){ const float dl=__builtin_fmaxf(rmr,0.f); mhat+=dl; \
        const float f=__builtin_amdgcn_exp2f(-dl); l_reg*=f; if(hi==0)wsf[r32]=f; resc=true; } } \
    SBAR(); \
    GAPB(o[0]=__builtin_amdgcn_mfma_f32_32x32x16_bf16(PAF(0),VFR(0),o[0],0,0,0), C0,0); \
    GAPB(o[1]=__builtin_amdgcn_mfma_f32_32x32x16_bf16(PAF(0),VFR(4),o[1],0,0,0), C0,4); \
    KRD(GL,0); GAPB(o[0]=__builtin_amdgcn_mfma_f32_32x32x16_bf16(PAF(1),VFR(1),o[0],0,0,0), C0,8); \
    KRD(GL,1); GAPB(o[1]=__builtin_amdgcn_mfma_f32_32x32x16_bf16(PAF(1),VFR(5),o[1],0,0,0), C0,12); \
    KRD(GL,2); GAPB(o[0]=__builtin_amdgcn_mfma_f32_32x32x16_bf16(PAF(2),VFR(2),o[0],0,0,0), C1,0); \
    KRD(GL,3); GAPB(o[1]=__builtin_amdgcn_mfma_f32_32x32x16_bf16(PAF(2),VFR(6),o[1],0,0,0), C1,4); \
    GAPB(o[0]=__builtin_amdgcn_mfma_f32_32x32x16_bf16(PAF(3),VFR(3),o[0],0,0,0), C1,8); \
    GAPB(o[1]=__builtin_amdgcn_mfma_f32_32x32x16_bf16(PAF(3),VFR(7),o[1],0,0,0), C1,12); \
    }while(0)
  int t=1; BINIT(pB0,pB1,1);
  #undef CMASK
  #define CMASK(P0,P1,t) do{}while(0)
  for(;t+5<NT;t+=2){
    STEP(pB0,pB1,pA0,pA1,t,true,true,true);     WAIT_BAR(2); RESC(); ROT();
    STEP(pA0,pA1,pB0,pB1,t+1,true,true,true);   WAIT_BAR(2); RESC(); ROT();
  }
  #undef CMASK
  #define CMASK(P0,P1,t) do{int jb_=(t)-(NT-4); if(jb_>=0)cmask(P0,P1,jb_,qrel,hi);}while(0)
  #define ENDW(tt) do{ if((tt)+3<NT){WAIT_BAR(2);} else if((tt)+2<NT){WAIT_BAR(1);} else {WAIT_BAR(0);} }while(0)
  for(;t+1<NT;t+=2){
    STEP(pB0,pB1,pA0,pA1,t,(t+3<NT),(t+1<NT),(t+1<NT));       ENDW(t);   RESC(); ROT();
    STEP(pA0,pA1,pB0,pB1,t+1,(t+4<NT),(t+2<NT),(t+2<NT));     ENDW(t+1); RESC(); ROT();
  }
  STEP(pB0,pB1,pA0,pA1,NT-1,false,false,false); RESC();
  { float sacc=pB0[0]+pB0[1]; _Pragma("unroll") for(int r=2;r<16;++r)sacc+=pB0[r]; _Pragma("unroll") for(int r=0;r<16;++r)sacc+=pB1[r]; l_reg+=sacc;
    pw0=(u32x4){PKW(pB0,0),PKW(pB0,2),PKW(pB0,4),PKW(pB0,6)};pw1=(u32x4){PKW(pB0,8),PKW(pB0,10),PKW(pB0,12),PKW(pB0,14)};pw2=(u32x4){PKW(pB1,0),PKW(pB1,2),PKW(pB1,4),PKW(pB1,6)};pw3=(u32x4){PKW(pB1,8),PKW(pB1,10),PKW(pB1,12),PKW(pB1,14)};
    SBAR(); pv(o,vb0+sl_cur,PAF(0),PAF(1),PAF(2),PAF(3)); }
  #undef PKW
  #undef PAF
  #undef VFR
  #undef PIN
  #undef MX3
  #undef GAPA
  #undef GAPB
  #undef EX
  #undef VRD
  #undef KRD
  #undef STEP
  #undef ENDW
  if(tid==0)qnext=atomicAdd(qctr,1u);
  {auto rr=__builtin_amdgcn_permlane32_swap(__float_as_uint(l_reg),__float_as_uint(l_reg),false,false);l_reg=__uint_as_float(rr[0])+__uint_as_float(rr[1]);}
  if(hi==0)wsf[32+r32]=l_reg;asm volatile("s_waitcnt lgkmcnt(0)":::"memory");
  float rli[16];
  #pragma unroll
  for(int r=0;r<16;++r)rli[r]=__builtin_amdgcn_rcpf(wsf[32+crow(r,hi)]);
  bf16*Ow=O+((long)b*FRAMES+qb*QB+wid*QBLK)*OPITCH+OCOL0+h*D;
  { bf16*stg=(bf16*)(shm+LDS_OST)+wid*2048;
    #pragma unroll
    for(int r=0;r<16;++r){const int orow=crow(r,hi);
      #pragma unroll
      for(int d0=0;d0<2;++d0)stg[orow*64+d0*32+r32]=__float2bfloat16(o[d0][r]*rli[r]);}
    asm volatile("s_waitcnt lgkmcnt(0)":::"memory");
    #pragma unroll
    for(int i=0;i<4;++i){const int row=i*8+(lane>>3),ch=lane&7; const u32x4 v=*(const u32x4*)(stg+row*64+ch*8); ATTN_STORE16(Ow+(long)row*OPITCH+ch*8,v);} }
  asm volatile("s_waitcnt lgkmcnt(0)\n\ts_barrier":::"memory");
  #undef DMA_K
  #undef DMA_V
  #undef CMASK
  #undef START
  #undef RESC
  #undef ROT
}
constexpr int ATTN_LDS_BYTES=LDS_BYTES;
#undef SBAR
#undef WAIT_BAR
}

#define GAS __attribute__((address_space(1)))
#define LAS __attribute__((address_space(3)))
typedef unsigned short bf16;
typedef unsigned v4u __attribute__((ext_vector_type(4)));
typedef unsigned v2u __attribute__((ext_vector_type(2)));
typedef float f32x4 __attribute__((ext_vector_type(4)));
typedef float f32x16v __attribute__((ext_vector_type(16)));
typedef short bf16x8v __attribute__((ext_vector_type(8)));

constexpr int NWAVES = 8, NTHR = 512;
constexpr int NB = 8, FR = 4096, LP = 4224, DM_ = 1024, MROWS = NB * FR, NPROJ = 3072, INW = 3080, DFF = 2816, NUP = 2 * DFF;
constexpr float EPS_ = 1e-6f, LOG2E = 1.4426950408889634f, C2Q = 0.125f * 1.4426950408889634f;
constexpr float BIAS_INVALID = -3000.0f;
constexpr int C_RQ = 0, C_RK = 256, C_RV = 512, C_RG = 1024, C_FQ = 1536, C_FK = 2048, C_FV = 2560;

constexpr size_t MiB = 1u << 20;
constexpr size_t WS_CTL = 0, CTL_ZERO_BYTES = 262144;
constexpr int CW_BAR = 4096, CW_PANEL = 8192;
static_assert((CW_PANEL + 64 * 128) * 4 <= (int)CTL_ZERO_BYTES, "ctl");
constexpr int CW_NORMS = 1024, CW_CENSUS = 2048, CW_FB = 16384, FB_SEAMS = 24;
static_assert((CW_FB + FB_SEAMS * 17 * 64) * 4 <= (int)CTL_ZERO_BYTES, "ctl");
constexpr int CW_BAR_ = 4096;
constexpr size_t WS_WIN = 2 * MiB, WS_WOUT = 8 * MiB, WS_WUP = 10 * MiB, WS_WDN = 21 * MiB;
constexpr size_t WS_ROPEC = 27 * MiB, WS_ROPES = 27 * MiB + 768 * 1024;
constexpr size_t WS_BIAS = 29 * MiB, WS_LOGF = 31 * MiB, WS_ROWSS = 32 * MiB, WS_ROWSS2 = 32 * MiB + 256 * 1024;
constexpr size_t WS_PROJM = 33 * MiB, WS_UMETA = 33 * MiB + 256 * 1024, WS_MIXM = 33 * MiB + 512 * 1024, WS_H1M = WS_MIXM + 16 * 1024, WS_AMETA = WS_MIXM + 32 * 1024, WS_LOGFM = WS_MIXM + 64 * 1024;
constexpr size_t WS_ATAIL = 34 * MiB, WS_AHEAD = 46 * MiB, WS_BHEAD = 58 * MiB;
constexpr size_t WS_XN = 70 * MiB, WS_MIXED = 134 * MiB, WS_H1 = 198 * MiB, WS_PROJ = 262 * MiB, WS_G = WS_PROJ, WS_END = 460 * MiB;
static_assert(WS_PROJ + (size_t)NB * LP * NPROJ * 2 <= WS_END && WS_G + (size_t)MROWS * DFF * 2 <= WS_END, "ws map");

constexpr int RING_BYTES = 131072, LDSCTL_OFF = RING_BYTES, LDS_BYTES = 147456;

struct Args {
    const float *x, *meta, *attn_g, *w_in, *fox_b, *ret_g, *w_out, *ffn_g, *w_up, *conv_w, *conv_b, *w_down, *final_g;
    float* out; unsigned char* ws;
};

__device__ __forceinline__ unsigned f2bf(float f) { unsigned u = __builtin_bit_cast(unsigned, f); return (u + 0x7fffu + ((u >> 16) & 1u)) >> 16; }
__device__ __forceinline__ unsigned pk2(float lo, float hi) { return f2bf(lo) | (f2bf(hi) << 16); }
__device__ __forceinline__ unsigned pk2h(float lo, float hi) { typedef float f2_ __attribute__((ext_vector_type(2))); typedef __bf16 b2_ __attribute__((ext_vector_type(2))); f2_ v = {lo, hi}; b2_ b = __builtin_convertvector(v, b2_); return __builtin_bit_cast(unsigned, b); }
__device__ __forceinline__ float bf2f(unsigned short v) { return __uint_as_float((unsigned)v << 16); }
__device__ __forceinline__ float wave_sum(float v) {
#pragma unroll
    for (int o = 1; o < 64; o <<= 1) v += __shfl_xor(v, o);
    return v;
}
__device__ __forceinline__ float logsigmoidf_(float z) { return fminf(z, 0.f) - log1pf(expf(-fabsf(z))); }
__device__ __forceinline__ float siluf_(float z) { return z / (1.0f + expf(-z)); }
#define LDS_WAIT() asm volatile("s_waitcnt lgkmcnt(0)" ::: "memory")
__device__ __forceinline__ int launder_v(int v) { asm volatile("" : "+v"(v)); return v; }
#define RELANE() do { tid = launder_v(tid); lane = tid & 63; wave = __builtin_amdgcn_readfirstlane(tid >> 6); } while (0)

__device__ __forceinline__ void p0_transpose_item(const float* W, int ldw, int src0, int k0, bf16* WT, int Kd, int drow0, const float* kg, float sc, LAS float* scr, int lane) {
    float wv[32];
#pragma unroll
    for (int i = 0; i < 32; ++i) wv[i] = __builtin_nontemporal_load(W + (size_t)(k0 + 2 * i + (lane >> 5)) * ldw + src0 + (lane & 31));
#pragma unroll
    for (int i = 0; i < 32; ++i) { const int kk = 2 * i + (lane >> 5); const float g = kg ? kg[k0 + kk] * sc : sc; scr[kk * 33 + (lane & 31)] = wv[i] * g; }
    LDS_WAIT(); asm volatile("" ::: "memory");
    const int c = lane & 7;
#pragma unroll
    for (int j = 0; j < 4; ++j) { const int n = (lane >> 3) + 8 * j; const LAS float* s = scr + (8 * c) * 33 + n;
        v4u o; o.x = pk2h(s[0 * 33], s[1 * 33]); o.y = pk2h(s[2 * 33], s[3 * 33]); o.z = pk2h(s[4 * 33], s[5 * 33]); o.w = pk2h(s[6 * 33], s[7 * 33]);
        *(GAS v4u*)(WT + (size_t)(drow0 + n) * Kd + k0 + 8 * c) = o; }
    LDS_WAIT(); asm volatile("" ::: "memory");
}

__device__ __forceinline__ void m0_item(const Args& A, LAS unsigned char* lds, int item, int tid, int lane, int wave) {
    RELANE();
    unsigned char* ws = A.ws;
    LAS float* hn = (LAS float*)lds;
    for (int rr = 0; rr < 2; ++rr) {
        const int r = 2 * wave + rr; float v[16]; float ss = 0.f;
#pragma unroll
        for (int j = 0; j < 4; ++j) { const f32x4 t = *(const f32x4*)(A.meta + (size_t)r * DM_ + 4 * lane + 256 * j); v[4 * j] = t[0]; v[4 * j + 1] = t[1]; v[4 * j + 2] = t[2]; v[4 * j + 3] = t[3]; ss += (t[0] * t[0] + t[1] * t[1]) + (t[2] * t[2] + t[3] * t[3]); }
        const float rs = 1.0f / sqrtf(wave_sum(ss) * (1.0f / DM_) + EPS_);
#pragma unroll
        for (int j = 0; j < 4; ++j)
#pragma unroll
            for (int i = 0; i < 4; ++i) { const int k = 4 * lane + 256 * j + i; hn[r * DM_ + k] = v[4 * j + i] * rs * A.attn_g[k]; }
    }
    __syncthreads();
    {
        const int c = tid & 15, ks = tid >> 4, n = 16 * item + c;
        float acc[16];
#pragma unroll
        for (int r = 0; r < 16; ++r) acc[r] = 0.f;
        if (n < INW) {
            const float* wp = A.w_in + (size_t)(32 * ks) * INW + n;
#pragma unroll 2
            for (int k4 = 0; k4 < 8; ++k4) { const float w0 = wp[(size_t)(4 * k4) * INW], w1 = wp[(size_t)(4 * k4 + 1) * INW], w2 = wp[(size_t)(4 * k4 + 2) * INW], w3 = wp[(size_t)(4 * k4 + 3) * INW];
#pragma unroll
                for (int r = 0; r < 16; ++r) { const f32x4 hv = *(const LAS f32x4*)(hn + r * DM_ + 32 * ks + 4 * k4);
                    acc[r] += (hv[0] * w0 + hv[1] * w1) + (hv[2] * w2 + hv[3] * w3); } }
        }
        LAS float* red = (LAS float*)(lds + 65536);
#pragma unroll
        for (int r = 0; r < 16; ++r) red[(ks * 16 + r) * 16 + c] = acc[r];
    }
    __syncthreads();
    if (tid < 256) {
        const LAS float* red = (const LAS float*)(lds + 65536);
        const int c = tid & 15, r = tid >> 4, n = 16 * item + c; float s = 0.f;
#pragma unroll
        for (int k = 0; k < 32; ++k) s += red[(k * 16 + r) * 16 + c];
        if (n < INW) {
            ((float*)(ws + WS_PROJM))[r * INW + n] = s;
            if (n >= C_FK && n < NPROJ) { const unsigned short bv = (unsigned short)f2bf(s); bf16* P = (bf16*)(ws + WS_PROJ);
#pragma unroll
                for (int b = 0; b < NB; ++b) P[(size_t)(b * LP + 112 + r) * NPROJ + n] = bv; }
            if (n >= NPROJ) ((float*)(ws + WS_LOGFM))[r * 8 + (n - NPROJ)] = logsigmoidf_(s + A.fox_b[n - NPROJ]);
        }
    }
    __syncthreads();
}

__device__ __forceinline__ void p0_prologue(const Args& A, LAS unsigned char* lds, int vcu, int G, int tid, int lane, int wave) {
    RELANE();
    unsigned char* ws = A.ws;
    const int gw = vcu * NWAVES + wave, NGW = G * NWAVES, gt = vcu * NTHR + tid, NGT = G * NTHR;
    for (int i = gt; i < MROWS; i += NGT) { ((float*)(ws + WS_ROWSS))[i] = 0.f; ((float*)(ws + WS_ROWSS2))[i] = 0.f; }
    if (vcu < 193) m0_item(A, lds, vcu, tid, lane, wave);
    RELANE();
    {
        LAS float* scr = (LAS float*)(lds + wave * 16384);
        constexpr int I_IN = 16 * 96, I_OUT = 16 * 32, I_UP = 16 * 176, I_DN = 44 * 32, NITEMS = I_IN + I_OUT + I_UP + I_DN;
        for (int it = gw; it < NITEMS; it += NGW) {
            int r = it;
            if (r < I_IN) { const int kb = r / 96, nb = r % 96; const float sc = (nb >= C_FQ / 32 && nb < C_FK / 32) ? C2Q : 1.0f;
                p0_transpose_item(A.w_in, INW, 32 * nb, 64 * kb, (bf16*)(ws + WS_WIN), DM_, 32 * nb, nullptr, sc, scr, lane); continue; } r -= I_IN;
            if (r < I_OUT) { const int kb = r / 32, nb = r % 32; p0_transpose_item(A.w_out, DM_, 32 * nb, 64 * kb, (bf16*)(ws + WS_WOUT), DM_, 32 * nb, nullptr, 1.0f, scr, lane); continue; } r -= I_OUT;
            if (r < I_UP) { const int kb = r / 176, nb = r % 176; const int n0 = 32 * nb, p = n0 >> 8, j = n0 & 255; const int src = (j < 128) ? (128 * p + j) : (DFF + 128 * p + (j - 128));
                p0_transpose_item(A.w_up, NUP, src, 64 * kb, (bf16*)(ws + WS_WUP), DM_, n0, A.ffn_g, 1.0f, scr, lane); continue; } r -= I_UP;
            { const int kb = r / 32, nb = r % 32; p0_transpose_item(A.w_down, DM_, 32 * nb, 64 * kb, (bf16*)(ws + WS_WDN), DFF, 32 * nb, nullptr, 1.0f, scr, lane); }
        }
    }
    for (int i = gt; i < LP * 32; i += NGT) { const int pos = i >> 5, j = i & 31;
        const double inv = exp(-9.210340371976184 * (double)j / 32.0);
        const double rev = (double)pos * inv * 0.15915494309189535; const float fr = (float)(rev - floor(rev));
        ((float*)(ws + WS_ROPEC))[i] = __builtin_amdgcn_cosf(fr); ((float*)(ws + WS_ROPES))[i] = __builtin_amdgcn_sinf(fr); }
    for (int i = gt; i < NB * 112 * 128; i += NGT) { const int ch = i & 127, rr = i >> 7, b = rr / 112, t = rr % 112;
        *(GAS v4u*)((bf16*)(ws + WS_PROJ) + (size_t)(b * LP + t) * NPROJ + C_FK + 8 * ch) = (v4u){0u, 0u, 0u, 0u}; }
    RELANE();
    {
        float wff[16][8], gk[16];
#pragma unroll
        for (int j = 0; j < 4; ++j)
#pragma unroll
            for (int i = 0; i < 4; ++i) { const int k = 4 * lane + 256 * j + i; gk[4 * j + i] = A.attn_g[k];
                const f32x4 a = *(const f32x4*)(A.w_in + (size_t)k * INW + NPROJ), b = *(const f32x4*)(A.w_in + (size_t)k * INW + NPROJ + 4);
                wff[4 * j + i][0] = a[0]; wff[4 * j + i][1] = a[1]; wff[4 * j + i][2] = a[2]; wff[4 * j + i][3] = a[3]; wff[4 * j + i][4] = b[0]; wff[4 * j + i][5] = b[1]; wff[4 * j + i][6] = b[2]; wff[4 * j + i][7] = b[3]; }
        const float fbc = A.fox_b[lane >> 3];
        f32x4 vn[4], vn2[4];
        if (gw < MROWS) { const GAS f32x4* xr = (const GAS f32x4*)(A.x + (size_t)gw * DM_) + lane;
#pragma unroll
            for (int j = 0; j < 4; ++j) vn[j] = __builtin_nontemporal_load(xr + 64 * j); }
        if (gw + NGW < MROWS) { const GAS f32x4* xr = (const GAS f32x4*)(A.x + (size_t)(gw + NGW) * DM_) + lane;
#pragma unroll
            for (int j = 0; j < 4; ++j) vn2[j] = __builtin_nontemporal_load(xr + 64 * j); }
        for (int m = gw; m < MROWS; m += NGW) {
            f32x4 v[4]; float ss = 0.f;
#pragma unroll
            for (int j = 0; j < 4; ++j) { v[j] = vn[j]; vn[j] = vn2[j]; ss += (v[j][0] * v[j][0] + v[j][1] * v[j][1]) + (v[j][2] * v[j][2] + v[j][3] * v[j][3]); }
            if (m + 2 * NGW < MROWS) { const GAS f32x4* xr = (const GAS f32x4*)(A.x + (size_t)(m + 2 * NGW) * DM_) + lane;
#pragma unroll
                for (int j = 0; j < 4; ++j) vn2[j] = __builtin_nontemporal_load(xr + 64 * j); }
            const float rs = 1.0f / sqrtf(wave_sum(ss) * (1.0f / DM_) + EPS_);
            float ff[8];
#pragma unroll
            for (int c = 0; c < 8; ++c) ff[c] = 0.f;
            GAS unsigned long long* o8 = (GAS unsigned long long*)((bf16*)(ws + WS_XN) + (size_t)m * DM_) + lane;
#pragma unroll
            for (int j = 0; j < 4; ++j) { float h[4];
#pragma unroll
                for (int i = 0; i < 4; ++i) { h[i] = v[j][i] * rs * gk[4 * j + i];
#pragma unroll
                    for (int c = 0; c < 8; ++c) ff[c] += h[i] * wff[4 * j + i][c]; }
                o8[64 * j] = (unsigned long long)pk2h(h[0], h[1]) | ((unsigned long long)pk2h(h[2], h[3]) << 32); }
            float r4[4], r2[2], r1;
            { const bool up = (lane & 32) != 0;
#pragma unroll
              for (int c = 0; c < 4; ++c) { const float keep = up ? ff[c + 4] : ff[c], send = up ? ff[c] : ff[c + 4]; r4[c] = keep + __shfl_xor(send, 32); } }
            { const bool up = (lane & 16) != 0;
#pragma unroll
              for (int c = 0; c < 2; ++c) { const float keep = up ? r4[c + 2] : r4[c], send = up ? r4[c] : r4[c + 2]; r2[c] = keep + __shfl_xor(send, 16); } }
            { const bool up = (lane & 8) != 0; const float keep = up ? r2[1] : r2[0], send = up ? r2[0] : r2[1]; r1 = keep + __shfl_xor(send, 8); }
            r1 += __shfl_xor(r1, 4); r1 += __shfl_xor(r1, 2); r1 += __shfl_xor(r1, 1);
            if ((lane & 7) == 0) { const int c = lane >> 3; ((float*)(ws + WS_LOGF))[(size_t)((m >> 12) * 8 + c) * FR + (m & (FR - 1))] = logsigmoidf_(r1 + fbc); }
        }
    }
}

__device__ __forceinline__ void cumsum_item(const Args& A, int bh, int lane) {
    lane = launder_v(lane);
    unsigned char* ws = A.ws; const int b = bh >> 3, h = bh & 7;
    float* bias = (float*)(ws + WS_BIAS) + (size_t)bh * LP; const float* lfm = (const float*)(ws + WS_LOGFM); const float* lf = (const float*)(ws + WS_LOGF) + (size_t)bh * FR + 64 * lane;
    f32x4 v[16];
#pragma unroll
    for (int i = 0; i < 16; ++i) v[i] = *(const f32x4*)(lf + 4 * i);
    for (int t = lane; t < 112; t += 64) bias[t] = BIAS_INVALID;
    { const float* pm = (const float*)(ws + WS_PROJM) + C_FK + h * 64 + lane; float mx = 0.f;
      float pv[16];
#pragma unroll
      for (int i = 0; i < 16; ++i) pv[i] = pm[i * INW];
#pragma unroll
      for (int i = 0; i < 16; ++i) mx = fmaxf(mx, wave_sum(pv[i] * pv[i]));
      if (lane == 0) ((unsigned*)(ws + WS_CTL))[CW_NORMS + ((b * 8 + h) * 3 + 2) * 2] = __float_as_uint(mx); }
    float c = 0.f;
    { const float my = (lane >= 1 && lane < 16) ? lfm[lane * 8 + h] : 0.f; float inc = my;
#pragma unroll
      for (int o = 1; o < 16; o <<= 1) { const float t = __shfl_up(inc, o); if (lane >= o) inc += t; }
      if (lane < 16) bias[112 + lane] = -inc * LOG2E;
      c = __shfl(inc, 15); }
    float loc = 0.f;
#pragma unroll
    for (int i = 0; i < 16; ++i) loc += (v[i][0] + v[i][1]) + (v[i][2] + v[i][3]);
    float inc = loc;
#pragma unroll
    for (int o = 1; o < 64; o <<= 1) { const float t = __shfl_up(inc, o); if (lane >= o) inc += t; }
    float run = c + (inc - loc);
    float* bo = bias + 128 + 64 * lane;
#pragma unroll
    for (int i = 0; i < 16; ++i) { f32x4 o; run += v[i][0]; o[0] = -run * LOG2E; run += v[i][1]; o[1] = -run * LOG2E; run += v[i][2]; o[2] = -run * LOG2E; run += v[i][3]; o[3] = -run * LOG2E; *(f32x4*)(bo + 4 * i) = o; }
}

__device__ __forceinline__ void m1_item(const Args& A, LAS unsigned char* lds, int item, int tid, int lane, int wave) {
    RELANE();
    unsigned char* ws = A.ws;
    const float* PM = (const float*)(ws + WS_PROJM); const float* LFM = (const float*)(ws + WS_LOGFM);
    const float* RC = (const float*)(ws + WS_ROPEC); const float* RS = (const float*)(ws + WS_ROPES);
    float* MIXM = (float*)(ws + WS_MIXM); float* UM = (float*)(ws + WS_UMETA);
    LAS float* kk = (LAS float*)lds;
    LAS float* qq = kk + 1024;
    LAS float* vv = qq + 128;
    LAS float* sc = vv + 2048;
    LAS float* part = sc + 32;
    if (item < 4) {
        const int h = item;
        const float lg = log2f(1.0f - exp2f(-5.0f - (float)h));
        { const int i = tid >> 5, j = tid & 31, pos = 112 + i; const float c = RC[pos * 32 + j], s = RS[pos * 32 + j];
          const float x1 = PM[i * INW + C_RK + h * 64 + j], x2 = PM[i * INW + C_RK + h * 64 + j + 32];
          kk[i * 64 + j] = (x1 * c - x2 * s) * 0.125f; kk[i * 64 + j + 32] = (x1 * s + x2 * c) * 0.125f; }
        if (tid < 64) { const int n = tid >> 5, j = tid & 31, i = 14 + n, pos = 112 + i; const float c = RC[pos * 32 + j], s = RS[pos * 32 + j];
          const float x1 = PM[i * INW + C_RQ + h * 64 + j], x2 = PM[i * INW + C_RQ + h * 64 + j + 32];
          qq[n * 64 + j] = x1 * c - x2 * s; qq[n * 64 + j + 32] = x1 * s + x2 * c; }
#pragma unroll
        for (int q = 0; q < 4; ++q) { const int idx = tid + 512 * q, i = idx >> 7, e = idx & 127; vv[idx] = PM[i * INW + C_RV + h * 128 + e]; }
        __syncthreads();
        float wgt[16];
#pragma unroll
        for (int i = 0; i < 16; ++i) wgt[i] = exp2f(lg * (float)(15 - i));
#pragma unroll 4
        for (int q = 0; q < 16; ++q) { const int idx = tid + 512 * q, d = idx >> 7, e = idx & 127; float s = 0.f;
#pragma unroll
            for (int i = 0; i < 16; ++i) s += wgt[i] * kk[i * 64 + d] * vv[i * 128 + e];
            UM[(size_t)h * 8192 + idx] = s; }
        if (tid < 32) { const int n = tid >> 4, i = tid & 15; float s = 0.f;
#pragma unroll 16
            for (int d = 0; d < 64; ++d) s += qq[n * 64 + d] * kk[i * 64 + d];
            sc[tid] = s * exp2f(lg * fabsf((float)(14 + n - i))); }
        __syncthreads();
        float o = 0.f;
        if (tid < 256) { const int n = tid >> 7, e = tid & 127;
#pragma unroll
            for (int i = 0; i < 16; ++i) o += sc[n * 16 + i] * vv[i * 128 + e]; }
        { const float p = wave_sum(o * o); if (lane == 0) part[wave] = p; }
        __syncthreads();
        if (tid < 256) { const int n = tid >> 7, e = tid & 127; const float ss = part[2 * n] + part[2 * n + 1];
            const float gate = PM[(14 + n) * INW + C_RG + h * 128 + e];
            MIXM[n * DM_ + h * 128 + e] = o * (1.0f / sqrtf(ss * (1.0f / 128.0f) + EPS_)) * A.ret_g[h * 128 + e] * siluf_(gate); }
    } else {
        const int hh = item - 4;
        for (int idx = tid; idx < 1024; idx += NTHR) { const int i = idx >> 6, d = idx & 63; kk[idx] = PM[i * INW + C_FK + hh * 64 + d]; vv[idx] = PM[i * INW + C_FV + hh * 64 + d]; }
        if (tid < 128) { const int n = tid >> 6, d = tid & 63; qq[tid] = PM[(14 + n) * INW + C_FQ + hh * 64 + d]; }
        __syncthreads();
        if (tid < 32) { const int n = tid >> 4, i = tid & 15, iq = 14 + n; float v = -INFINITY;
            if (i <= iq) { float s = 0.f;
#pragma unroll 16
                for (int d = 0; d < 64; ++d) s += qq[n * 64 + d] * kk[i * 64 + d];
                float cb = 0.f; for (int j = i + 1; j <= iq; ++j) cb += LFM[j * 8 + hh];
                v = s * 0.125f + cb; }
            sc[tid] = v; }
        __syncthreads();
        if (tid < 128) { const int n = tid >> 6, d = tid & 63; float mx = -INFINITY;
#pragma unroll
            for (int i = 0; i < 16; ++i) mx = fmaxf(mx, sc[n * 16 + i]);
            float l = 0.f, o = 0.f;
#pragma unroll
            for (int i = 0; i < 16; ++i) { const float p = expf(sc[n * 16 + i] - mx); l += p; o += p * vv[i * 64 + d]; }
            MIXM[n * DM_ + 512 + hh * 64 + d] = o / l; }
    }
    __syncthreads();
}

__device__ __forceinline__ void m2_item(const Args& A, LAS unsigned char* lds, int item, int tid) {
    tid = launder_v(tid);
    unsigned char* ws = A.ws; const float* MIXM = (const float*)(ws + WS_MIXM); float* H1M = (float*)(ws + WS_H1M);
    LAS float* red = (LAS float*)lds;
    const int c = tid & 15, ks = tid >> 4, col = 16 * item + c;
    { const float* wp = A.w_out + (size_t)(32 * ks) * DM_ + col; const float* mp = MIXM + 32 * ks;
      float w[32];
#pragma unroll
      for (int k = 0; k < 32; ++k) w[k] = wp[(size_t)k * DM_];
      float s0 = 0.f, s1 = 0.f;
#pragma unroll
      for (int k = 0; k < 32; ++k) { s0 += mp[k] * w[k]; s1 += mp[DM_ + k] * w[k]; }
      red[(ks * 2 + 0) * 16 + c] = s0; red[(ks * 2 + 1) * 16 + c] = s1; }
    __syncthreads();
    if (tid < 32) { const int n = tid >> 4, cc = tid & 15; float s = 0.f;
#pragma unroll
        for (int k = 0; k < 32; ++k) s += red[(k * 2 + n) * 16 + cc];
        H1M[n * DM_ + 16 * item + cc] = A.meta[(size_t)(14 + n) * DM_ + 16 * item + cc] + s; }
    __syncthreads();
}
__device__ __forceinline__ void m3_item(const Args& A, LAS unsigned char* lds, int item, int tid, int lane, int wave) {
    RELANE();
    unsigned char* ws = A.ws; const float* H1M = (const float*)(ws + WS_H1M); float* AM = (float*)(ws + WS_AMETA);
    LAS float* red = (LAS float*)lds; LAS float* part = red + 1024;
    { float a = 0.f; const int n = tid >> 8, k0 = (tid & 255) * 4;
      const f32x4 t = *(const f32x4*)(H1M + n * DM_ + k0); a = (t[0] * t[0] + t[1] * t[1]) + (t[2] * t[2] + t[3] * t[3]);
      a = wave_sum(a); if (lane == 0) part[wave] = a; }
    const int c = tid & 15, ks = tid >> 4, col = 16 * item + c;
    { const float* wp = A.w_up + (size_t)(32 * ks) * NUP + col; const float* hp = H1M + 32 * ks; const float* gp = A.ffn_g + 32 * ks;
      float w[32];
#pragma unroll
      for (int k = 0; k < 32; ++k) w[k] = wp[(size_t)k * NUP];
      float s0 = 0.f, s1 = 0.f;
#pragma unroll
      for (int k = 0; k < 32; ++k) { const float gw = gp[k] * w[k]; s0 += hp[k] * gw; s1 += hp[DM_ + k] * gw; }
      red[(ks * 2 + 0) * 16 + c] = s0; red[(ks * 2 + 1) * 16 + c] = s1; }
    __syncthreads();
    if (tid < 32) { const int n = tid >> 4, cc = tid & 15; float s = 0.f;
#pragma unroll
        for (int k = 0; k < 32; ++k) s += red[(k * 2 + n) * 16 + cc];
        const float rs = 1.0f / sqrtf(((part[4 * n] + part[4 * n + 1]) + (part[4 * n + 2] + part[4 * n + 3])) * (1.0f / DM_) + EPS_);
        AM[n * DFF + 16 * item + cc] = rs * s; }
    __syncthreads();
}

namespace ret {
constexpr int RS = 72;
constexpr int O_QR = 0, O_QW = 9216, O_KR = 18432, O_KWT = 27648, O_P = 36864, O_VT = 46080, O_RT = 64512, O_SS = 82944, LDS_USED = 83968;
__device__ __forceinline__ unsigned cvtpk(float lo, float hi) { typedef float f2 __attribute__((ext_vector_type(2))); typedef __bf16 b2 __attribute__((ext_vector_type(2))); f2 v = {lo, hi}; b2 b = __builtin_convertvector(v, b2); return __builtin_bit_cast(unsigned, b); }
__device__ __forceinline__ int crow(int r, int hi) { return (r & 3) + 8 * (r >> 2) + 4 * hi; }
__device__ __forceinline__ bf16x8v ldfrag(const LAS unsigned char* base, int row, int kel) { return *(const LAS bf16x8v*)(base + (row * RS + kel) * 2); }

__device__ __forceinline__ void item(const Args& A, LAS unsigned char* lds, int b, int h, int part, int tid, int lane, int wave) {
    RELANE();
    unsigned char* ws = A.ws;
    const bf16* PROJ = (const bf16*)(ws + WS_PROJ) + (size_t)(b * LP + 128) * NPROJ;
    const float* RC = (const float*)(ws + WS_ROPEC); const float* RSN = (const float*)(ws + WS_ROPES);
    bf16* MIX = (bf16*)(ws + WS_MIXED) + (size_t)b * FR * DM_ + h * 128;
    const float lg = log2f(1.0f - exp2f(-5.0f - (float)h));
    const float g64 = exp2f(lg * 64.0f);
    const int r32 = lane & 31, hi = lane >> 5;
    const int sn = tid >> 3, sj = (tid & 7) * 4;
    const int vm = (tid & 31) * 2, ve = (tid >> 5) * 8;
    const float wq = exp2f(lg * (float)(sn + 1)), wk = exp2f(lg * (float)(63 - sn));
    const int ob_e = wave & 3, ob_n = wave >> 2;
    const int rb_k = wave >> 2, rb_e = wave & 3;
    const int sb_m = wave & 1, sb_n = (wave >> 1) & 1;
    f32x16v R;
    { const float* um = (const float*)(ws + WS_UMETA) + (size_t)h * 8192;
#pragma unroll
      for (int r = 0; r < 16; ++r) R[r] = um[(32 * rb_k + crow(r, hi)) * 128 + 32 * rb_e + r32]; }
    float gv[16];
#pragma unroll
    for (int r = 0; r < 16; ++r) gv[r] = A.ret_g[h * 128 + 32 * ob_e + crow(r, hi)];
#define RET_PREFETCH(S, ci) do { const bf16* rowp = PROJ + (size_t)(64 * (ci) + sn) * NPROJ; \
        pq0_##S = *(const v2u*)(rowp + C_RQ + h * 64 + sj); pq1_##S = *(const v2u*)(rowp + C_RQ + h * 64 + 32 + sj); \
        pk0_##S = *(const v2u*)(rowp + C_RK + h * 64 + sj); pk1_##S = *(const v2u*)(rowp + C_RK + h * 64 + 32 + sj); \
        const bf16* vp = PROJ + (size_t)(64 * (ci) + vm) * NPROJ + C_RV + h * 128 + ve; pv0_##S = *(const v4u*)vp; pv1_##S = *(const v4u*)(vp + NPROJ); \
        const int pos = 128 + 64 * (ci) + sn; pc_##S = *(const f32x4*)(RC + pos * 32 + sj); ps_##S = *(const f32x4*)(RSN + pos * 32 + sj); } while (0)
#define RET_PREFETCH_G(S, ci) do { const bf16* gp = PROJ + (size_t)(64 * (ci) + 32 * ob_n + r32) * NPROJ + C_RG + h * 128 + 32 * ob_e + 4 * hi; \
        _Pragma("unroll") for (int q = 0; q < 4; ++q) pg_##S[q] = *(const v2u*)(gp + 8 * q); } while (0)
#define RET_BAR() do { asm volatile("s_waitcnt lgkmcnt(0)" ::: "memory"); __builtin_amdgcn_s_barrier(); asm volatile("" ::: "memory"); } while (0)
    v2u pq0_A, pq1_A, pk0_A, pk1_A; v4u pv0_A, pv1_A; v2u pg_A[4]; f32x4 pc_A, ps_A;
    v2u pq0_B, pq1_B, pk0_B, pk1_B; v4u pv0_B, pv1_B; v2u pg_B[4]; f32x4 pc_B, ps_B;
    constexpr int XA = 32, XB = 52;
    const int c_begin = part == 0 ? 0 : (part == 1 ? XA : XB), c_end = part == 0 ? XA : (part == 1 ? XB : 64);
    if (part >= 1) {
        const int nkeep = (int)(40.0f / (-64.0f * lg)) + 2;
        const int c_s0 = (c_begin - nkeep > 0) ? ((c_begin - nkeep) & ~1) : 0;
        if (c_s0 > 0) {
#pragma unroll
            for (int r = 0; r < 16; ++r) R[r] = 0.f;
        }
        RET_PREFETCH(A, c_s0); RET_PREFETCH(B, c_s0 + 1);
#define RET_STATE_CHUNK(S, ci) do { \
            float k1[4], k2[4]; \
            k1[0] = __uint_as_float(pk0_##S[0] << 16); k1[1] = __uint_as_float(pk0_##S[0] & 0xffff0000u); k1[2] = __uint_as_float(pk0_##S[1] << 16); k1[3] = __uint_as_float(pk0_##S[1] & 0xffff0000u); \
            k2[0] = __uint_as_float(pk1_##S[0] << 16); k2[1] = __uint_as_float(pk1_##S[0] & 0xffff0000u); k2[2] = __uint_as_float(pk1_##S[1] << 16); k2[3] = __uint_as_float(pk1_##S[1] & 0xffff0000u); \
            float ka[4], kb[4]; \
            _Pragma("unroll") for (int i = 0; i < 4; ++i) { ka[i] = (k1[i] * pc_##S[i] - k2[i] * ps_##S[i]) * (0.125f * wk); kb[i] = (k1[i] * ps_##S[i] + k2[i] * pc_##S[i]) * (0.125f * wk); } \
            _Pragma("unroll") for (int i = 0; i < 4; i += 2) { const unsigned wa = cvtpk(ka[i], ka[i + 1]), wb = cvtpk(kb[i], kb[i + 1]); \
                *(LAS unsigned short*)(lds + O_KWT + ((sj + i) * RS + sn) * 2) = (unsigned short)wa; *(LAS unsigned short*)(lds + O_KWT + ((sj + i + 1) * RS + sn) * 2) = (unsigned short)(wa >> 16); \
                *(LAS unsigned short*)(lds + O_KWT + ((32 + sj + i) * RS + sn) * 2) = (unsigned short)wb; *(LAS unsigned short*)(lds + O_KWT + ((32 + sj + i + 1) * RS + sn) * 2) = (unsigned short)(wb >> 16); } \
            _Pragma("unroll") for (int i = 0; i < 4; ++i) { const unsigned a = pv0_##S[i], c = pv1_##S[i]; \
                *(LAS unsigned*)(lds + O_VT + ((ve + 2 * i) * RS + vm) * 2) = (a & 0xffffu) | (c << 16); \
                *(LAS unsigned*)(lds + O_VT + ((ve + 2 * i + 1) * RS + vm) * 2) = (a >> 16) | (c & 0xffff0000u); } \
            RET_BAR(); \
            if ((ci) + 2 < c_begin) RET_PREFETCH(S, (ci) + 2); \
            _Pragma("unroll") for (int r = 0; r < 16; ++r) R[r] *= g64; \
            _Pragma("unroll") for (int ks = 0; ks < 4; ++ks) R = __builtin_amdgcn_mfma_f32_32x32x16_bf16(ldfrag(lds + O_KWT, 32 * rb_k + r32, 16 * ks + 8 * hi), ldfrag(lds + O_VT, 32 * rb_e + r32, 16 * ks + 8 * hi), R, 0, 0, 0); \
            RET_BAR(); } while (0)
        for (int c2 = c_s0; c2 < c_begin; c2 += 2) { RET_STATE_CHUNK(A, c2); RET_STATE_CHUNK(B, c2 + 1); }
#undef RET_STATE_CHUNK
    }
    RET_PREFETCH(A, c_begin); RET_PREFETCH(B, c_begin + 1); RET_PREFETCH_G(A, c_begin); RET_PREFETCH_G(B, c_begin + 1);
    for (int c2 = c_begin; c2 < c_end; c2 += 2) {
      { const int ci = c2;
        {
            float q1[4], q2[4], k1[4], k2[4];
            q1[0] = __uint_as_float(pq0_A[0] << 16); q1[1] = __uint_as_float(pq0_A[0] & 0xffff0000u); q1[2] = __uint_as_float(pq0_A[1] << 16); q1[3] = __uint_as_float(pq0_A[1] & 0xffff0000u);
            q2[0] = __uint_as_float(pq1_A[0] << 16); q2[1] = __uint_as_float(pq1_A[0] & 0xffff0000u); q2[2] = __uint_as_float(pq1_A[1] << 16); q2[3] = __uint_as_float(pq1_A[1] & 0xffff0000u);
            k1[0] = __uint_as_float(pk0_A[0] << 16); k1[1] = __uint_as_float(pk0_A[0] & 0xffff0000u); k1[2] = __uint_as_float(pk0_A[1] << 16); k1[3] = __uint_as_float(pk0_A[1] & 0xffff0000u);
            k2[0] = __uint_as_float(pk1_A[0] << 16); k2[1] = __uint_as_float(pk1_A[0] & 0xffff0000u); k2[2] = __uint_as_float(pk1_A[1] << 16); k2[3] = __uint_as_float(pk1_A[1] & 0xffff0000u);
            float qa[4], qb[4], ka[4], kb[4];
#pragma unroll
            for (int i = 0; i < 4; ++i) { qa[i] = q1[i] * pc_A[i] - q2[i] * ps_A[i]; qb[i] = q1[i] * ps_A[i] + q2[i] * pc_A[i];
                ka[i] = (k1[i] * pc_A[i] - k2[i] * ps_A[i]) * 0.125f; kb[i] = (k1[i] * ps_A[i] + k2[i] * pc_A[i]) * 0.125f; }
            *(LAS v2u*)(lds + O_QR + (sn * RS + sj) * 2) = (v2u){cvtpk(qa[0], qa[1]), cvtpk(qa[2], qa[3])};
            *(LAS v2u*)(lds + O_QR + (sn * RS + 32 + sj) * 2) = (v2u){cvtpk(qb[0], qb[1]), cvtpk(qb[2], qb[3])};
            *(LAS v2u*)(lds + O_QW + (sn * RS + sj) * 2) = (v2u){cvtpk(qa[0] * wq, qa[1] * wq), cvtpk(qa[2] * wq, qa[3] * wq)};
            *(LAS v2u*)(lds + O_QW + (sn * RS + 32 + sj) * 2) = (v2u){cvtpk(qb[0] * wq, qb[1] * wq), cvtpk(qb[2] * wq, qb[3] * wq)};
            *(LAS v2u*)(lds + O_KR + (sn * RS + sj) * 2) = (v2u){cvtpk(ka[0], ka[1]), cvtpk(ka[2], ka[3])};
            *(LAS v2u*)(lds + O_KR + (sn * RS + 32 + sj) * 2) = (v2u){cvtpk(kb[0], kb[1]), cvtpk(kb[2], kb[3])};
#pragma unroll
            for (int i = 0; i < 4; i += 2) { const unsigned wa = cvtpk(ka[i] * wk, ka[i + 1] * wk), wb = cvtpk(kb[i] * wk, kb[i + 1] * wk);
                *(LAS unsigned short*)(lds + O_KWT + ((sj + i) * RS + sn) * 2) = (unsigned short)wa; *(LAS unsigned short*)(lds + O_KWT + ((sj + i + 1) * RS + sn) * 2) = (unsigned short)(wa >> 16);
                *(LAS unsigned short*)(lds + O_KWT + ((32 + sj + i) * RS + sn) * 2) = (unsigned short)wb; *(LAS unsigned short*)(lds + O_KWT + ((32 + sj + i + 1) * RS + sn) * 2) = (unsigned short)(wb >> 16); }
#pragma unroll
            for (int i = 0; i < 4; ++i) { const unsigned a = pv0_A[i], c = pv1_A[i];
                *(LAS unsigned*)(lds + O_VT + ((ve + 2 * i) * RS + vm) * 2) = (a & 0xffffu) | (c << 16);
                *(LAS unsigned*)(lds + O_VT + ((ve + 2 * i + 1) * RS + vm) * 2) = (a >> 16) | (c & 0xffff0000u); }
#pragma unroll
            for (int g = 0; g < 4; ++g) *(LAS v2u*)(lds + O_RT + ((32 * rb_e + r32) * RS + 32 * rb_k + 8 * g + 4 * hi) * 2) = (v2u){cvtpk(R[4 * g], R[4 * g + 1]), cvtpk(R[4 * g + 2], R[4 * g + 3])};
        }
        RET_BAR();
        if (ci + 2 < c_end) RET_PREFETCH(A, ci + 2);
        if (wave < 4) {
            f32x16v s = {};
#pragma unroll
            for (int ks = 0; ks < 4; ++ks) s = __builtin_amdgcn_mfma_f32_32x32x16_bf16(ldfrag(lds + O_KR, 32 * sb_m + r32, 16 * ks + 8 * hi), ldfrag(lds + O_QR, 32 * sb_n + r32, 16 * ks + 8 * hi), s, 0, 0, 0);
            const int n = 32 * sb_n + r32;
#pragma unroll
            for (int g = 0; g < 4; ++g) { float pvv[4];
#pragma unroll
                for (int i = 0; i < 4; ++i) { const int m = 32 * sb_m + 8 * g + 4 * hi + i; pvv[i] = s[4 * g + i] * __builtin_amdgcn_exp2f(lg * fabsf((float)(n - m))); }
                *(LAS v2u*)(lds + O_P + (n * RS + 32 * sb_m + 8 * g + 4 * hi) * 2) = (v2u){cvtpk(pvv[0], pvv[1]), cvtpk(pvv[2], pvv[3])}; }
        }
        f32x16v o = {};
#pragma unroll
        for (int ks = 0; ks < 4; ++ks) o = __builtin_amdgcn_mfma_f32_32x32x16_bf16(ldfrag(lds + O_RT, 32 * ob_e + r32, 16 * ks + 8 * hi), ldfrag(lds + O_QW, 32 * ob_n + r32, 16 * ks + 8 * hi), o, 0, 0, 0);
#pragma unroll
        for (int r = 0; r < 16; ++r) R[r] *= g64;
#pragma unroll
        for (int ks = 0; ks < 4; ++ks) R = __builtin_amdgcn_mfma_f32_32x32x16_bf16(ldfrag(lds + O_KWT, 32 * rb_k + r32, 16 * ks + 8 * hi), ldfrag(lds + O_VT, 32 * rb_e + r32, 16 * ks + 8 * hi), R, 0, 0, 0);
        RET_BAR();
#pragma unroll
        for (int ks = 0; ks < 4; ++ks) o = __builtin_amdgcn_mfma_f32_32x32x16_bf16(ldfrag(lds + O_VT, 32 * ob_e + r32, 16 * ks + 8 * hi), ldfrag(lds + O_P, 32 * ob_n + r32, 16 * ks + 8 * hi), o, 0, 0, 0);
        { float ss = 0.f;
#pragma unroll
          for (int r = 0; r < 16; ++r) ss += o[r] * o[r];
          ss += __shfl_xor(ss, 32);
          if (hi == 0) *(LAS float*)(lds + O_SS + ((32 * ob_n + r32) * 4 + ob_e) * 4) = ss; }
        RET_BAR();
        { const f32x4 p4 = *(const LAS f32x4*)(lds + O_SS + (32 * ob_n + r32) * 16);
          const float rs = __builtin_amdgcn_rsqf(((p4[0] + p4[1]) + (p4[2] + p4[3])) * (1.0f / 128.0f) + EPS_);
          bf16* op = MIX + (size_t)(64 * ci + 32 * ob_n + r32) * DM_ + 32 * ob_e + 4 * hi;
#pragma unroll
          for (int g = 0; g < 4; ++g) { float y[4]; float zz[4];
              zz[0] = __uint_as_float(pg_A[g][0] << 16); zz[1] = __uint_as_float(pg_A[g][0] & 0xffff0000u); zz[2] = __uint_as_float(pg_A[g][1] << 16); zz[3] = __uint_as_float(pg_A[g][1] & 0xffff0000u);
#pragma unroll
              for (int i = 0; i < 4; ++i) { const float z = zz[i]; y[i] = o[4 * g + i] * rs * gv[4 * g + i] * z * __builtin_amdgcn_rcpf(1.0f + __expf(-z)); }
              *(v2u*)(op + 8 * g) = (v2u){cvtpk(y[0], y[1]), cvtpk(y[2], y[3])}; } }
        if (ci + 2 < c_end) RET_PREFETCH_G(A, ci + 2);
          }
      { const int ci = c2 + 1;
        {
            float q1[4], q2[4], k1[4], k2[4];
            q1[0] = __uint_as_float(pq0_B[0] << 16); q1[1] = __uint_as_float(pq0_B[0] & 0xffff0000u); q1[2] = __uint_as_float(pq0_B[1] << 16); q1[3] = __uint_as_float(pq0_B[1] & 0xffff0000u);
            q2[0] = __uint_as_float(pq1_B[0] << 16); q2[1] = __uint_as_float(pq1_B[0] & 0xffff0000u); q2[2] = __uint_as_float(pq1_B[1] << 16); q2[3] = __uint_as_float(pq1_B[1] & 0xffff0000u);
            k1[0] = __uint_as_float(pk0_B[0] << 16); k1[1] = __uint_as_float(pk0_B[0] & 0xffff0000u); k1[2] = __uint_as_float(pk0_B[1] << 16); k1[3] = __uint_as_float(pk0_B[1] & 0xffff0000u);
            k2[0] = __uint_as_float(pk1_B[0] << 16); k2[1] = __uint_as_float(pk1_B[0] & 0xffff0000u); k2[2] = __uint_as_float(pk1_B[1] << 16); k2[3] = __uint_as_float(pk1_B[1] & 0xffff0000u);
            float qa[4], qb[4], ka[4], kb[4];
#pragma unroll
            for (int i = 0; i < 4; ++i) { qa[i] = q1[i] * pc_B[i] - q2[i] * ps_B[i]; qb[i] = q1[i] * ps_B[i] + q2[i] * pc_B[i];
                ka[i] = (k1[i] * pc_B[i] - k2[i] * ps_B[i]) * 0.125f; kb[i] = (k1[i] * ps_B[i] + k2[i] * pc_B[i]) * 0.125f; }
            *(LAS v2u*)(lds + O_QR + (sn * RS + sj) * 2) = (v2u){cvtpk(qa[0], qa[1]), cvtpk(qa[2], qa[3])};
            *(LAS v2u*)(lds + O_QR + (sn * RS + 32 + sj) * 2) = (v2u){cvtpk(qb[0], qb[1]), cvtpk(qb[2], qb[3])};
            *(LAS v2u*)(lds + O_QW + (sn * RS + sj) * 2) = (v2u){cvtpk(qa[0] * wq, qa[1] * wq), cvtpk(qa[2] * wq, qa[3] * wq)};
            *(LAS v2u*)(lds + O_QW + (sn * RS + 32 + sj) * 2) = (v2u){cvtpk(qb[0] * wq, qb[1] * wq), cvtpk(qb[2] * wq, qb[3] * wq)};
            *(LAS v2u*)(lds + O_KR + (sn * RS + sj) * 2) = (v2u){cvtpk(ka[0], ka[1]), cvtpk(ka[2], ka[3])};
            *(LAS v2u*)(lds + O_KR + (sn * RS + 32 + sj) * 2) = (v2u){cvtpk(kb[0], kb[1]), cvtpk(kb[2], kb[3])};
#pragma unroll
            for (int i = 0; i < 4; i += 2) { const unsigned wa = cvtpk(ka[i] * wk, ka[i + 1] * wk), wb = cvtpk(kb[i] * wk, kb[i + 1] * wk);
                *(LAS unsigned short*)(lds + O_KWT + ((sj + i) * RS + sn) * 2) = (unsigned short)wa; *(LAS unsigned short*)(lds + O_KWT + ((sj + i + 1) * RS + sn) * 2) = (unsigned short)(wa >> 16);
                *(LAS unsigned short*)(lds + O_KWT + ((32 + sj + i) * RS + sn) * 2) = (unsigned short)wb; *(LAS unsigned short*)(lds + O_KWT + ((32 + sj + i + 1) * RS + sn) * 2) = (unsigned short)(wb >> 16); }
#pragma unroll
            for (int i = 0; i < 4; ++i) { const unsigned a = pv0_B[i], c = pv1_B[i];
                *(LAS unsigned*)(lds + O_VT + ((ve + 2 * i) * RS + vm) * 2) = (a & 0xffffu) | (c << 16);
                *(LAS unsigned*)(lds + O_VT + ((ve + 2 * i + 1) * RS + vm) * 2) = (a >> 16) | (c & 0xffff0000u); }
#pragma unroll
            for (int g = 0; g < 4; ++g) *(LAS v2u*)(lds + O_RT + ((32 * rb_e + r32) * RS + 32 * rb_k + 8 * g + 4 * hi) * 2) = (v2u){cvtpk(R[4 * g], R[4 * g + 1]), cvtpk(R[4 * g + 2], R[4 * g + 3])};
        }
        RET_BAR();
        if (ci + 2 < c_end) RET_PREFETCH(B, ci + 2);
        if (wave < 4) {
            f32x16v s = {};
#pragma unroll
            for (int ks = 0; ks < 4; ++ks) s = __builtin_amdgcn_mfma_f32_32x32x16_bf16(ldfrag(lds + O_KR, 32 * sb_m + r32, 16 * ks + 8 * hi), ldfrag(lds + O_QR, 32 * sb_n + r32, 16 * ks + 8 * hi), s, 0, 0, 0);
            const int n = 32 * sb_n + r32;
#pragma unroll
            for (int g = 0; g < 4; ++g) { float pvv[4];
#pragma unroll
                for (int i = 0; i < 4; ++i) { const int m = 32 * sb_m + 8 * g + 4 * hi + i; pvv[i] = s[4 * g + i] * __builtin_amdgcn_exp2f(lg * fabsf((float)(n - m))); }
                *(LAS v2u*)(lds + O_P + (n * RS + 32 * sb_m + 8 * g + 4 * hi) * 2) = (v2u){cvtpk(pvv[0], pvv[1]), cvtpk(pvv[2], pvv[3])}; }
        }
        f32x16v o = {};
#pragma unroll
        for (int ks = 0; ks < 4; ++ks) o = __builtin_amdgcn_mfma_f32_32x32x16_bf16(ldfrag(lds + O_RT, 32 * ob_e + r32, 16 * ks + 8 * hi), ldfrag(lds + O_QW, 32 * ob_n + r32, 16 * ks + 8 * hi), o, 0, 0, 0);
#pragma unroll
        for (int r = 0; r < 16; ++r) R[r] *= g64;
#pragma unroll
        for (int ks = 0; ks < 4; ++ks) R = __builtin_amdgcn_mfma_f32_32x32x16_bf16(ldfrag(lds + O_KWT, 32 * rb_k + r32, 16 * ks + 8 * hi), ldfrag(lds + O_VT, 32 * rb_e + r32, 16 * ks + 8 * hi), R, 0, 0, 0);
        RET_BAR();
#pragma unroll
        for (int ks = 0; ks < 4; ++ks) o = __builtin_amdgcn_mfma_f32_32x32x16_bf16(ldfrag(lds + O_VT, 32 * ob_e + r32, 16 * ks + 8 * hi), ldfrag(lds + O_P, 32 * ob_n + r32, 16 * ks + 8 * hi), o, 0, 0, 0);
        { float ss = 0.f;
#pragma unroll
          for (int r = 0; r < 16; ++r) ss += o[r] * o[r];
          ss += __shfl_xor(ss, 32);
          if (hi == 0) *(LAS float*)(lds + O_SS + ((32 * ob_n + r32) * 4 + ob_e) * 4) = ss; }
        RET_BAR();
        { const f32x4 p4 = *(const LAS f32x4*)(lds + O_SS + (32 * ob_n + r32) * 16);
          const float rs = __builtin_amdgcn_rsqf(((p4[0] + p4[1]) + (p4[2] + p4[3])) * (1.0f / 128.0f) + EPS_);
          bf16* op = MIX + (size_t)(64 * ci + 32 * ob_n + r32) * DM_ + 32 * ob_e + 4 * hi;
#pragma unroll
          for (int g = 0; g < 4; ++g) { float y[4]; float zz[4];
              zz[0] = __uint_as_float(pg_B[g][0] << 16); zz[1] = __uint_as_float(pg_B[g][0] & 0xffff0000u); zz[2] = __uint_as_float(pg_B[g][1] << 16); zz[3] = __uint_as_float(pg_B[g][1] & 0xffff0000u);
#pragma unroll
              for (int i = 0; i < 4; ++i) { const float z = zz[i]; y[i] = o[4 * g + i] * rs * gv[4 * g + i] * z * __builtin_amdgcn_rcpf(1.0f + __expf(-z)); }
              *(v2u*)(op + 8 * g) = (v2u){cvtpk(y[0], y[1]), cvtpk(y[2], y[3])}; } }
        if (ci + 2 < c_end) RET_PREFETCH_G(B, ci + 2);
          }
    }
#undef RET_PREFETCH
#undef RET_PREFETCH_G
#undef RET_BAR
    __syncthreads();
}
}

__device__ __forceinline__ void fixup_phase(const Args& A, int vcu, int G, int tid) {
    tid = launder_v(tid);
    unsigned char* ws = A.ws; const float* AT = (const float*)(ws + WS_ATAIL); const float* AH = (const float*)(ws + WS_AHEAD); const float* BH = (const float*)(ws + WS_BHEAD); const float* AM = (const float*)(ws + WS_AMETA);
    bf16* Gm = (bf16*)(ws + WS_G);
    const int NIT = 512 * 2 * (DFF / 8);
    for (int it = vcu * NTHR + tid; it < NIT; it += G * NTHR) {
        const int cg8 = it % (DFF / 8), sr = it / (DFF / 8), sidx = sr >> 1, j = sr & 1, f0 = 8 * cg8;
        const float* pm2; const float* pm1;
        const float* t0 = (sidx & 63) ? AT + (size_t)((sidx - 1) * 2) * DFF : AM;
        const float* h0 = AH + (size_t)(sidx * 2) * DFF;
        if (j == 0) { pm2 = t0; pm1 = t0 + DFF; } else { pm2 = t0 + DFF; pm1 = h0; }
        const float* pa = h0 + (size_t)j * DFF; const float* pb = BH + (size_t)(sidx * 2 + j) * DFF;
        float g[8];
#pragma unroll
        for (int c = 0; c < 8; ++c) { const int f = f0 + c;
            const float z = A.conv_b[f] + A.conv_w[f] * pm2[f] + A.conv_w[DFF + f] * pm1[f] + A.conv_w[2 * DFF + f] * pa[f];
            g[c] = z * pb[f] / (1.0f + __expf(-z)); }
        *(v4u*)(Gm + (size_t)(sidx * 64 + j) * DFF + f0) = (v4u){pk2(g[0], g[1]), pk2(g[2], g[3]), pk2(g[4], g[5]), pk2(g[6], g[7])};
    }
}

__device__ __forceinline__ void final_norm_phase(const Args& A, int vcu, int G, int lane, int wave) {
    { int tid = launder_v((int)threadIdx.x); lane = tid & 63; wave = __builtin_amdgcn_readfirstlane(tid >> 6); }
    const float* ss2 = (const float*)(A.ws + WS_ROWSS2);
    f32x4 gk[4];
#pragma unroll
    for (int j = 0; j < 4; ++j) gk[j] = *(const f32x4*)(A.final_g + 4 * lane + 256 * j);
    for (int m = vcu * NWAVES + wave; m < MROWS; m += G * NWAVES) {
        GAS f32x4* p = (GAS f32x4*)(A.out + (size_t)m * DM_) + lane;
        const float rs = 1.0f / sqrtf(ss2[m] * (1.0f / DM_) + EPS_);
#pragma unroll
        for (int j = 0; j < 4; ++j) { f32x4 v = p[64 * j]; p[64 * j] = v * rs * gk[j]; }
    }
}

#define FB_WORD(s, j) (CW_FB + ((s) * 17 + (j)) * 64)
__device__ __forceinline__ unsigned fb_xcc_id() { return (unsigned)__builtin_amdgcn_s_getreg((3 << 11) | 20) & 0xFu; }
struct FBar { unsigned* ctl; volatile LAS unsigned* st; unsigned x; };
__device__ __forceinline__ void fbar_census(const FBar& b) {
    if (threadIdx.x == 0) { unsigned mine = 0u, cnt = 0u, sum = 0u, sp = 0u; const unsigned G = gridDim.x;
        for (;;) { mine = 0u; cnt = 0u; sum = 0u;
            for (unsigned j = 0; j < 16; ++j) { const unsigned c = __hip_atomic_load(b.ctl + CW_CENSUS + 64 * j, __ATOMIC_RELAXED, __HIP_MEMORY_SCOPE_AGENT); sum += c; cnt += (c > 0u) ? 1u : 0u; mine = (j == b.x) ? c : mine; }
            if (sum == G || ++sp > (1u << 20)) break;
            __builtin_amdgcn_s_sleep(1); }
        b.st[0] = mine > 0u ? mine : 1u; b.st[1] = cnt > 0u ? cnt : 1u; }
    __syncthreads();
}
template <bool FENCE = true> __device__ __forceinline__ void fbar(const FBar& b, int seam) {
    asm volatile("s_waitcnt vmcnt(0)" ::: "memory");
    __syncthreads();
    if (threadIdx.x == 0) {
        const unsigned nloc = b.st[0], nx = b.st[1];
        unsigned* top = b.ctl + FB_WORD(seam, 16);
        const unsigned old = __hip_atomic_fetch_add(b.ctl + FB_WORD(seam, b.x), 1u, __ATOMIC_RELAXED, __HIP_MEMORY_SCOPE_AGENT);
        if (old + 1u == nloc) {
            if (FENCE) { __builtin_amdgcn_fence(__ATOMIC_RELEASE, "agent"); asm volatile("s_waitcnt vmcnt(0)" ::: "memory"); }
            __hip_atomic_fetch_add(top, 1u, __ATOMIC_RELAXED, __HIP_MEMORY_SCOPE_AGENT);
        }
        unsigned sp = 0u;
        while (__hip_atomic_load(top, __ATOMIC_RELAXED, __HIP_MEMORY_SCOPE_AGENT) < nx && ++sp < (1u << 20)) __builtin_amdgcn_s_sleep(1);
        if (FENCE) { __builtin_amdgcn_fence(__ATOMIC_ACQUIRE, "agent"); asm volatile("s_waitcnt vmcnt(0)" ::: "memory"); }
    }
    __syncthreads();
}
constexpr int Q_RET = 96, Q_ATT = 1024, Q_M2 = 64, Q_TOTAL = Q_RET + Q_ATT + Q_M2;

__global__ void __launch_bounds__(NTHR, 2) hymba_fwd(Args args) {
    extern __shared__ __attribute__((aligned(16))) unsigned char lds_raw[];
    LAS unsigned char* lds = (LAS unsigned char*)lds_raw;
    cg::grid_group grid = cg::this_grid();
    const int tid = threadIdx.x, lane = tid & 63, wave = __builtin_amdgcn_readfirstlane(tid >> 6);
    const int G = gridDim.x, bid = blockIdx.x;
    const int vcu = (G % 8 == 0) ? (bid % 8) * (G / 8) + bid / 8 : bid;
    unsigned char* ws = args.ws;
    volatile LAS unsigned* MISC = (volatile LAS unsigned*)(lds + LDSCTL_OFF);
    if (tid < 64) MISC[tid] = 0u;
    __syncthreads();
    FBar bar; bar.ctl = (unsigned*)(ws + WS_CTL); bar.st = MISC + 8; bar.x = fb_xcc_id();
    for (int i = bid * NTHR + tid; i < (int)(CTL_ZERO_BYTES / 4); i += G * NTHR) bar.ctl[i] = 0u;
    int seam_no = 0;
#define SEAM() do { fbar(bar, seam_no); ++seam_no; } while (0)
    grid.sync();
    if (tid == 0) __hip_atomic_fetch_add(bar.ctl + CW_CENSUS + 64 * bar.x, 1u, __ATOMIC_RELAXED, __HIP_MEMORY_SCOPE_AGENT);

#ifndef SKIP_P0
    p0_prologue(args, lds, vcu, G, tid, lane, wave);
#endif
    fbar_census(bar);
    SEAM();
#ifdef DUP_P0
    p0_prologue(args, lds, vcu, G, tid, lane, wave);
    SEAM();
#endif
#ifdef DUP_SYNC
    for (int i_ = 0; i_ < 8; ++i_) SEAM();
#endif
#ifdef DUP_SYNC_NF
    for (int i_ = 0; i_ < 8; ++i_) { fbar<false>(bar, seam_no); ++seam_no; }
#endif

    {
    if (bid < 64 && wave == 0) cumsum_item(args, bid, lane);
#ifndef SKIP_M1
    if (bid >= G - 12) m1_item(args, lds, G - 1 - bid, tid, lane, wave);
#endif
    __syncthreads();
    {
        pg8::Gemm g{(const pg8::bf16_t*)(ws + WS_XN), (const pg8::bf16_t*)(ws + WS_WIN), MROWS, NPROJ, DM_}; pg8::StaticOrder S; S.init(MROWS, NPROJ, G, bid);
        pg8::EpiProj E{(pg8::bf16_t*)(ws + WS_PROJ), NPROJ, (unsigned*)(ws + WS_CTL) + CW_NORMS};
#ifndef SKIP_G1
        pg8::gemm_phase<pg8::EpiProj, pg8::StaticOrder, true, true>(lds, g, S, E);
#endif
#ifdef DUP_P1
        SEAM();
        pg8::gemm_phase<pg8::EpiProj, pg8::StaticOrder, true, true>(lds, g, S, E);
#endif
    }
    SEAM();
    }

    {
#ifdef DUP_P2
      for (int rep_ = 0; rep_ < 2; ++rep_) {
        unsigned* ctr = (unsigned*)(ws + WS_CTL) + rep_;
#else
      {
        unsigned* ctr = (unsigned*)(ws + WS_CTL);
#endif
        unsigned qnext = 0u; bool have_next = false;
        for (;;) {
            if (have_next) { if (tid == 0) MISC[0] = qnext; __syncthreads(); }
            else { __syncthreads(); if (tid == 0) MISC[0] = atomicAdd(ctr, 1u); __syncthreads(); }
            have_next = false;
            const int it = __builtin_amdgcn_readfirstlane((int)MISC[0]);
            if (it >= Q_TOTAL) break;
            if (it < Q_RET) {
#ifndef SKIP_RET
                ret::item(args, lds, (it & 31) >> 2, it & 3, 2 - (it >> 5), tid, lane, wave);
#endif
            }
            else if (it < Q_RET + Q_ATT) { const int a = it - Q_RET, qb = 15 - (a >> 6), bh = a & 63;
                const attn_body::bf16* P = (const attn_body::bf16*)(ws + WS_PROJ); (void)P; (void)qb; (void)bh;
#ifndef SKIP_ATT
                int t0;
                { const unsigned* nq = (const unsigned*)(ws + WS_CTL) + CW_NORMS + bh * 6; const float* bs = (const float*)(ws + WS_BIAS) + (size_t)bh * LP;
                  const int q0 = 128 + 256 * qb, ntm4 = (q0 + 256) / 64 - 4, ln = launder_v(lane);
                  const float bq = bs[q0], bk = bs[64 * ((ln < ntm4) ? ln : 0) + 63];
                  const float q2 = __uint_as_float(nq[0]) + __uint_as_float(nq[1]), k2 = fmaxf(__uint_as_float(nq[2]) + __uint_as_float(nq[3]), __uint_as_float(nq[4]));
                  const float thresh = 2.1f * sqrtf(q2 * k2) + 40.0f;
                  const unsigned long long skip = __ballot((ln < ntm4) && (bq - bk >= thresh));
                  const int cnt = __builtin_amdgcn_readfirstlane((int)__builtin_ctzll(~skip));
                  t0 = (cnt < ntm4 ? cnt : ntm4) & ~1; }
                attn_body::attn_unit<60>(bh >> 3, bh & 7, qb, P + C_FQ, P + C_FK, P + C_FV, (attn_body::bf16*)(ws + WS_MIXED), (const float*)(ws + WS_BIAS), t0, ctr, qnext, (char*)lds_raw);
                have_next = true;
#endif
            }
            else m2_item(args, lds, it - Q_RET - Q_ATT, tid);
        }
#ifdef DUP_RET
        __syncthreads();
        if (bid < 64) ret::item(args, lds, (bid & 31) >> 2, bid & 3, (bid < 32) ? 1 : 0, tid, lane, wave);
#endif
#ifdef DUP_ATT
        __syncthreads();
        for (int i_ = 0; i_ < 4; ++i_) { const int a = bid * 4 + i_, qb = ((i_ & 1) ? 15 - (a >> 6) : (a >> 6)), bh = a & 63;
            const attn_body::bf16* P = (const attn_body::bf16*)(ws + WS_PROJ);
            attn_body::attn_unit<8>(bh >> 3, bh & 7, qb, P + C_FQ, P + C_FK, P + C_FV, (attn_body::bf16*)(ws + WS_MIXED), (const float*)(ws + WS_BIAS), 0, ctr + 8, qnext, (char*)lds_raw); }
#endif
#ifdef DUP_P2
        SEAM();
#endif
      }
    }
#ifndef DUP_P2
    SEAM();
#endif

    if (bid < 176) m3_item(args, lds, bid, tid, lane, wave);
    __syncthreads();
    {
        pg8::Gemm g{(const pg8::bf16_t*)(ws + WS_MIXED), (const pg8::bf16_t*)(ws + WS_WOUT), MROWS, DM_, DM_}; pg8::StaticOrder S; S.init(MROWS, DM_, G, bid);
        pg8::EpiRes1 E{args.x, (pg8::bf16_t*)(ws + WS_H1), (float*)(ws + WS_ROWSS), DM_};
#ifndef SKIP_G3
        pg8::gemm_phase<pg8::EpiRes1, pg8::StaticOrder, true, true>(lds, g, S, E);
#endif
#ifdef DUP_P3
        SEAM();
        { pg8::EpiRes1 E2{args.x, (pg8::bf16_t*)(ws + WS_H1), nullptr, DM_}; pg8::gemm_phase<pg8::EpiRes1, pg8::StaticOrder, true, true>(lds, g, S, E2); }
#endif
    }
    SEAM();

#ifdef DUP_P4
    for (int rep_ = 0; rep_ < 2; ++rep_)
#endif
    {
    {
        pg8::Gemm g{(const pg8::bf16_t*)(ws + WS_H1), (const pg8::bf16_t*)(ws + WS_WUP), MROWS, NUP, DM_}; pg8::StaticOrder S; S.init(MROWS, NUP, G, bid);
        pg8::EpiUp E{(pg8::bf16_t*)(ws + WS_G), (const float*)(ws + WS_ROWSS), args.conv_w, args.conv_b, (float*)(ws + WS_ATAIL), (float*)(ws + WS_AHEAD), (float*)(ws + WS_BHEAD)};
#ifndef SKIP_G4
        pg8::gemm_phase<pg8::EpiUp, pg8::StaticOrder, true, true>(lds, g, S, E);
#endif
    }
    SEAM();
    }
    fixup_phase(args, vcu, G, tid);
    SEAM();

    {
        pg8::Gemm g{(const pg8::bf16_t*)(ws + WS_G), (const pg8::bf16_t*)(ws + WS_WDN), MROWS, DM_, DFF}; pg8::StaticOrder S; S.init(MROWS, DM_, G, bid);
#ifdef DUP_P5
        { pg8::EpiRes1 E2{args.x, (pg8::bf16_t*)(ws + WS_XN), nullptr, DM_}; pg8::gemm_phase<pg8::EpiRes1, pg8::StaticOrder, true, true>(lds, g, S, E2); }
        SEAM();
#endif
#ifndef SKIP_G5
        if (G == 256) {
            pg8::EpiRes2N E{(const pg8::bf16_t*)(ws + WS_H1), args.out, (float*)(ws + WS_ROWSS2), (unsigned*)(ws + WS_CTL) + CW_PANEL, args.final_g, DM_};
            pg8::gemm_phase<pg8::EpiRes2N, pg8::StaticOrder, true, true>(lds, g, S, E);
        } else {
            pg8::EpiRes2 E{(const pg8::bf16_t*)(ws + WS_H1), args.out, (float*)(ws + WS_ROWSS2), DM_};
            pg8::gemm_phase<pg8::EpiRes2, pg8::StaticOrder, true, true>(lds, g, S, E);
        }
#endif
    }
    if (G != 256) {
        SEAM();
        final_norm_phase(args, vcu, G, lane, wave);
    }
}

extern "C" void kernel_launch(void* const* d_in, const int* in_sizes, int n_in, void* d_out, int out_size, void* d_ws, size_t ws_size, hipStream_t stream) {
    static int grid = 0;
    if (grid == 0) {
        if (n_in != 13 || in_sizes[0] != MROWS * DM_ || out_size != MROWS * DM_ || ws_size < WS_END) {
            fprintf(stderr, "kernel_launch: unexpected shapes (n_in %d, in0 %d, out %d, ws %zu); nothing launched\n", n_in, n_in > 0 ? in_sizes[0] : -1, out_size, ws_size); grid = -1; return; }
        int dev = 0, cus = 0, per_cu = 0;
        hipGetDevice(&dev); hipDeviceGetAttribute(&cus, hipDeviceAttributeMultiprocessorCount, dev);
        if (hipFuncSetAttribute((const void*)hymba_fwd, hipFuncAttributeMaxDynamicSharedMemorySize, LDS_BYTES) != hipSuccess) { fprintf(stderr, "kernel_launch: hipFuncSetAttribute failed\n"); grid = -1; return; }
        if (hipOccupancyMaxActiveBlocksPerMultiprocessor(&per_cu, (const void*)hymba_fwd, NTHR, LDS_BYTES) != hipSuccess || per_cu < 1) { fprintf(stderr, "kernel_launch: occupancy query says %d blocks per CU\n", per_cu); per_cu = 1; }
        (void)hipGetLastError();
        grid = cus * per_cu;
    }
    if (grid < 0) return;
    Args a{};
    a.x = (const float*)d_in[0]; a.meta = (const float*)d_in[1]; a.attn_g = (const float*)d_in[2]; a.w_in = (const float*)d_in[3]; a.fox_b = (const float*)d_in[4];
    a.ret_g = (const float*)d_in[5]; a.w_out = (const float*)d_in[6]; a.ffn_g = (const float*)d_in[7]; a.w_up = (const float*)d_in[8]; a.conv_w = (const float*)d_in[9];
    a.conv_b = (const float*)d_in[10]; a.w_down = (const float*)d_in[11]; a.final_g = (const float*)d_in[12];
    a.out = (float*)d_out; a.ws = (unsigned char*)d_ws;
    void* kargs[] = {&a};
    const hipError_t e = hipLaunchCooperativeKernel((const void*)hymba_fwd, dim3(grid), dim3(NTHR), kargs, LDS_BYTES, stream);
    if (e != hipSuccess) fprintf(stderr, "kernel_launch: cooperative launch failed: %s (grid %d)\n", hipGetErrorString(e), grid);
}
```
